# Optimizing an MI355X kernel written in HIP

```python
import jax, jax.numpy as jnp
from jax import lax
import numpy as np

D_MODEL = 1024
BATCH = 8
SEQ = 8192
DEPTH = 1

CHUNK = 64
N_HEADS = 4
HEAD_DIM = D_MODEL // 8
D_MLSTM = N_HEADS * HEAD_DIM
CONV_WIDTH = 4
POOL_WINDOWS = (2, 4, 8, 16)
N_POOL_GROUPS = len(POOL_WINDOWS)
POOL_GROUP_DIM = D_MODEL // 8
D_POOL = N_POOL_GROUPS * POOL_GROUP_DIM
D_FF = 256 * ((8 * D_MODEL // 3 + 255) // 256)
FFN_RES_WEIGHT = 0.5
NORM_EPS = 1e-6
FORGET_BIAS = 3.0
IN_SIZES = (2 * D_MLSTM, D_MLSTM, D_MLSTM, D_POOL, D_MODEL, D_MODEL, N_HEADS, N_HEADS)
D_IN = sum(IN_SIZES)

kernel_name = "hybrid_mlstm_pool_macaron"


def rms_norm(x, g):
    xf = x.astype(jnp.float32)
    y = xf * lax.rsqrt(jnp.mean(xf * xf, axis=-1, keepdims=True) + NORM_EPS)
    return (y * g.astype(jnp.float32)).astype(x.dtype)


def swiglu_ffn(x, w_gu, w_down):
    gate, up = jnp.split(x @ w_gu, 2, axis=-1)
    return (jax.nn.silu(gate) * up) @ w_down


def causal_depthwise_conv(x, w):
    k = w.shape[0]
    return lax.conv_general_dilated(
        x, w[:, None, :].astype(x.dtype), window_strides=(1,), padding=[(k - 1, 0)],
        dimension_numbers=("NWC", "WIO", "NWC"), feature_group_count=x.shape[-1])


def mlstm_chunkwise(q, k, v, i_pre, f_pre):
    b_sz, s_len, n_h, d_h = q.shape
    n_c = s_len // CHUNK
    f32 = jnp.float32

    def to_chunks(t):
        t = t.astype(f32).reshape((b_sz, n_c, CHUNK, n_h) + t.shape[3:])
        return jnp.moveaxis(t, (1, 3), (0, 2))

    qc = to_chunks(q)
    kc = to_chunks(k) * (d_h ** -0.5)
    vc = to_chunks(v)
    ic = to_chunks(i_pre)
    fc = to_chunks(jax.nn.log_sigmoid(f_pre.astype(f32)))
    causal = jnp.tril(jnp.ones((CHUNK, CHUNK), dtype=bool))

    def step(carry, xs):
        c_st, n_st, m_st = carry
        q_, k_, v_, i_, lf_ = xs
        b = jnp.cumsum(lf_, axis=-1)
        a_inter = b + m_st[..., None]
        d_log = jnp.where(causal, b[..., :, None] - b[..., None, :] + i_[..., None, :], -jnp.inf)
        m_t = jnp.maximum(a_inter, jnp.max(d_log, axis=-1))
        w_inter = jnp.exp(a_inter - m_t)
        s_qk = jnp.einsum("bhtd,bhsd->bhts", q_, k_) * jnp.exp(d_log - m_t[..., None])
        num = (w_inter[..., None] * jnp.einsum("bhvd,bhtd->bhtv", c_st, q_)
               + jnp.einsum("bhts,bhsv->bhtv", s_qk, v_))
        den = w_inter * jnp.einsum("bhd,bhtd->bht", n_st, q_) + jnp.sum(s_qk, axis=-1)
        h = num / jnp.maximum(jnp.abs(den), jnp.exp(-m_t))[..., None]
        g_s = b[..., -1:] - b + i_
        m_new = jnp.maximum(b[..., -1] + m_st, jnp.max(g_s, axis=-1))
        decay = jnp.exp(b[..., -1] + m_st - m_new)
        w_s = jnp.exp(g_s - m_new[..., None])
        c_new = decay[..., None, None] * c_st + jnp.einsum("bhs,bhsv,bhsd->bhvd", w_s, v_, k_)
        n_new = decay[..., None] * n_st + jnp.einsum("bhs,bhsd->bhd", w_s, k_)
        return (c_new, n_new, m_new), h

    init = (jnp.zeros((b_sz, n_h, d_h, d_h), f32), jnp.zeros((b_sz, n_h, d_h), f32),
            jnp.zeros((b_sz, n_h), f32))
    _, h = lax.scan(step, init, (qc, kc, vc, ic, fc))
    return jnp.moveaxis(h, (0, 2), (1, 3)).reshape(b_sz, s_len, n_h * d_h)


def multiscale_pool(u):
    b_sz, s_len, _ = u.shape
    uf = u.astype(jnp.float32).reshape(b_sz, s_len, N_POOL_GROUPS, POOL_GROUP_DIM)
    csum = jnp.pad(jnp.cumsum(uf, axis=1), ((0, 0), (1, 0), (0, 0), (0, 0)))
    pos = jnp.arange(1, s_len + 1, dtype=jnp.float32)
    groups = []
    for gi, win in enumerate(POOL_WINDOWS):
        upper = csum[:, 1:, gi]
        lower = jnp.pad(csum[:, :s_len + 1 - win, gi], ((0, 0), (win - 1, 0), (0, 0)))
        count = jnp.minimum(pos, float(win))[None, :, None]
        groups.append((upper - lower) / count - uf[:, :, gi])
    return jnp.stack(groups, axis=2)


def hybrid_mixer(h, w_in, b_in, conv_qk, head_norm_g, p_a, w_pool, pool_scale, p_b, w_out):
    b_sz, s_len, _ = h.shape
    z = h @ w_in + b_in
    parts = []
    start = 0
    for size in IN_SIZES:
        parts.append(z[..., start:start + size])
        start += size
    qk, v, o, u, gate_a, gate_b, i_pre, f_pre = parts
    qk = jax.nn.silu(causal_depthwise_conv(qk, conv_qk))
    q, k = jnp.split(qk, 2, axis=-1)
    hs = (b_sz, s_len, N_HEADS, HEAD_DIM)
    y_a = mlstm_chunkwise(q.reshape(hs), k.reshape(hs), v.reshape(hs), i_pre, f_pre)
    y_a = y_a.reshape(hs)
    y_a = (y_a * lax.rsqrt(jnp.mean(y_a * y_a, axis=-1, keepdims=True) + NORM_EPS)).reshape(b_sz, s_len, D_MLSTM)
    y_a = (y_a * head_norm_g.astype(jnp.float32) * jax.nn.sigmoid(o.astype(jnp.float32))).astype(h.dtype)
    pooled = multiscale_pool(u)
    y_b = jnp.einsum("bsgc,gcd->bsgd", pooled.astype(h.dtype), w_pool).reshape(b_sz, s_len, D_POOL) * pool_scale
    merged = jax.nn.sigmoid(gate_a) * (y_a @ p_a) + jax.nn.sigmoid(gate_b) * (y_b @ p_b)
    return merged @ w_out


def setup_inputs(seed: int = 0) -> dict:
    key = jax.random.key(seed)
    ks = jax.random.split(key, 20)
    L = DEPTH
    nrm = lambda k, shape, fan: jax.random.normal(k, shape, jnp.float32) * (fan ** -0.5)
    gain = lambda k, shape: 1.0 + 0.05 * jax.random.normal(k, shape, jnp.float32)
    f_offset = jnp.zeros((D_IN,), jnp.float32).at[D_IN - N_HEADS:].set(FORGET_BIAS)
    b_in = 0.02 * jax.random.normal(ks[5], (L, D_IN), jnp.float32) + f_offset
    return {
        "x": jax.random.normal(ks[0], (BATCH, SEQ, D_MODEL), jnp.float32),
        "ffn1_norm_g": gain(ks[1], (L, D_MODEL)),
        "ffn1_w_gu": nrm(ks[2], (L, D_MODEL, 2 * D_FF), D_MODEL),
        "ffn1_w_down": nrm(ks[3], (L, D_FF, D_MODEL), D_FF),
        "mix_norm_g": gain(ks[4], (L, D_MODEL)),
        "w_in": nrm(ks[6], (L, D_MODEL, D_IN), D_MODEL),
        "b_in": b_in,
        "conv_qk": nrm(ks[7], (L, CONV_WIDTH, 2 * D_MLSTM), CONV_WIDTH),
        "head_norm_g": gain(ks[8], (L, D_MLSTM)),
        "p_a": nrm(ks[9], (L, D_MLSTM, D_MODEL), D_MLSTM),
        "w_pool": nrm(ks[10], (L, N_POOL_GROUPS, POOL_GROUP_DIM, POOL_GROUP_DIM), POOL_GROUP_DIM),
        "pool_scale": gain(ks[11], (L, D_POOL)),
        "p_b": nrm(ks[12], (L, D_POOL, D_MODEL), D_POOL),
        "w_out": nrm(ks[13], (L, D_MODEL, D_MODEL), D_MODEL),
        "ffn2_norm_g": gain(ks[14], (L, D_MODEL)),
        "ffn2_w_gu": nrm(ks[15], (L, D_MODEL, 2 * D_FF), D_MODEL),
        "ffn2_w_down": nrm(ks[16], (L, D_FF, D_MODEL), D_FF),
        "final_norm_g": gain(ks[17], (D_MODEL,)),
    }


def reference(x, ffn1_norm_g, ffn1_w_gu, ffn1_w_down, mix_norm_g, w_in, b_in, conv_qk,
              head_norm_g, p_a, w_pool, pool_scale, p_b, w_out, ffn2_norm_g, ffn2_w_gu,
              ffn2_w_down, final_norm_g):
    for l in range(DEPTH):
        x = x + FFN_RES_WEIGHT * swiglu_ffn(rms_norm(x, ffn1_norm_g[l]), ffn1_w_gu[l], ffn1_w_down[l])
        x = x + hybrid_mixer(rms_norm(x, mix_norm_g[l]), w_in[l], b_in[l], conv_qk[l], head_norm_g[l],
                             p_a[l], w_pool[l], pool_scale[l], p_b[l], w_out[l])
        x = x + FFN_RES_WEIGHT * swiglu_ffn(rms_norm(x, ffn2_norm_g[l]), ffn2_w_gu[l], ffn2_w_down[l])
    return rms_norm(x, final_norm_g)
```

```cpp
#include <hip/hip_runtime.h>
#include <cstdio>

#ifndef MK_N_LAUNCHES
#define MK_N_LAUNCHES 1
#endif
#ifndef EN_MIX
#define EN_MIX 1
#endif
#ifndef EN_FFN2
#define EN_FFN2 1
#endif
#ifndef EN_MLSTM
#define EN_MLSTM 1
#endif
#ifndef P5_CONSTBM
#define P5_CONSTBM 0
#endif
#ifndef P5_NODN
#define P5_NODN 0
#endif
#ifndef P6_SANITIZE
#define P6_SANITIZE 0
#endif
#ifndef P4_SYNTH
#define P4_SYNTH 0
#endif
#ifndef P5_ZERO
#define P5_ZERO 0
#endif
#ifndef P6_NOSTATE
#define P6_NOSTATE 0
#endif

#define LAS __attribute__((address_space(3)))
#define GAS __attribute__((address_space(1)))
typedef unsigned short bf16_t;
typedef short bf16x8 __attribute__((ext_vector_type(8)));
typedef float f32x4 __attribute__((ext_vector_type(4)));
typedef float f32x2 __attribute__((ext_vector_type(2)));
typedef unsigned u32x4 __attribute__((ext_vector_type(4)));
typedef unsigned u32x2 __attribute__((ext_vector_type(2)));
typedef GAS unsigned gu32;

constexpr int BATCH = 8, SEQ = 8192, D = 1024, M = BATCH * SEQ, DFF = 2816, NGU = 2 * DFF;
constexpr int NH = 4, DH = 128, CH = 64, NCH = SEQ / CH, NUNIT = BATCH * NCH * NH;
constexpr int DIN = 4616, NIN = 4864, ZW = 4608;
constexpr int ZC_Q = 0, ZC_K = 512, ZC_V = 1024, ZC_O = 1536, ZC_U = 2048, ZC_GA = 2560, ZC_GB = 3584;
constexpr float EPS = 1e-6f;
constexpr int NPHASE = 12;

constexpr size_t MiB = 1u << 20;
constexpr size_t WS_CTL = 0, CTL_ZERO_BYTES = 1 * MiB;
constexpr size_t WS_WGU1 = 1 * MiB;
constexpr size_t WS_WDN1 = WS_WGU1 + (size_t)NGU * D * 2;
constexpr size_t WS_WIN = WS_WDN1 + (size_t)D * DFF * 2;
constexpr size_t WS_WAB = WS_WIN + (size_t)NIN * D * 2;
constexpr size_t WS_WOUT = WS_WAB + (size_t)D * D * 2;
constexpr size_t WS_WGU2 = WS_WOUT + (size_t)D * D * 2;
constexpr size_t WS_WDN2 = WS_WGU2 + (size_t)NGU * D * 2;
constexpr size_t WS_WEND = WS_WDN2 + (size_t)D * DFF * 2;
constexpr size_t WS_SS = 48 * MiB;
constexpr size_t WS_ZIF = 49 * MiB;
constexpr size_t WS_NST = 51 * MiB;
constexpr size_t WS_UB = 53 * MiB, WS_UM = WS_UB + 65536, WS_UMS = WS_UM + 65536;
constexpr size_t WS_NST2 = 54 * MiB;
constexpr size_t WS_H = 64 * MiB;
constexpr size_t WS_A2 = 192 * MiB;
constexpr size_t WS_CST = 320 * MiB;
constexpr size_t WS_Z = 448 * MiB;
constexpr size_t WS_END = 1024 * MiB;
static_assert(WS_WEND <= WS_SS && WS_Z + (size_t)M * ZW * 2 <= WS_END && WS_CST + (size_t)NUNIT * DH * DH * 2 <= WS_Z, "ws map");
constexpr int CW_TMO = 0, CW_BAR = 4096;

constexpr int RING_BYTES = 131072, EPI_OFF = RING_BYTES, EPI_BYTES = 4096, MISC_OFF = EPI_OFF + EPI_BYTES, LDS_BYTES = 147456;

#define RLX_AGENT __ATOMIC_RELAXED, __HIP_MEMORY_SCOPE_AGENT
typedef __bf16 bf16x2_t __attribute__((ext_vector_type(2)));
__device__ __forceinline__ unsigned cvt_pk_bf16(float lo, float hi) { const f32x2 v = {lo, hi}; return __builtin_bit_cast(unsigned, __builtin_convertvector(v, bf16x2_t)); }
__device__ __forceinline__ float bf_lo(unsigned w) { return __uint_as_float(w << 16); }
__device__ __forceinline__ float bf_hi(unsigned w) { return __uint_as_float(w & 0xffff0000u); }
__device__ __forceinline__ float fast_exp(float x) { return __builtin_amdgcn_exp2f(x * 1.44269504089f); }
__device__ __forceinline__ float fast_sigmoid(float x) { return __builtin_amdgcn_rcpf(1.0f + fast_exp(-x)); }

#define XB_TMO      128
#define XB_XCNT(j)  (256  + 64 * (j))
#define XB_XSUB(j)  (1280 + 64 * (j))
#define XB_XGEN(j)  (2304 + 64 * (j))
#define XB_TOP      3328
#define XB_TOPGEN   3392
#define XCD_BAR_WORDS 3456
#define XB_SPIN_CAP (1u << 18)
__device__ __forceinline__ unsigned xb_ld(unsigned* p)              { return __hip_atomic_load(p, __ATOMIC_RELAXED, __HIP_MEMORY_SCOPE_AGENT); }
__device__ __forceinline__ unsigned xb_add(unsigned* p, unsigned v) { return __hip_atomic_fetch_add(p, v, __ATOMIC_RELAXED, __HIP_MEMORY_SCOPE_AGENT); }
__device__ __forceinline__ unsigned xb_xcc_id() { return (unsigned)__builtin_amdgcn_s_getreg((3 << 11) | 20) & 0xFu; }
#define XB_SPIN(cond, bar) do { unsigned _sp = 0; while (cond) { __builtin_amdgcn_s_sleep(1); \
    if ((++_sp & 255u) == 0u) { if (xb_ld(&(bar)[XB_TMO])) break; if (_sp > XB_SPIN_CAP) { atomicAdd(&(bar)[XB_TMO], 1u); break; } } } } while (0)
struct XcdBarrier { unsigned* bar; unsigned x; volatile LAS unsigned* st; };
__device__ __forceinline__ XcdBarrier xcd_barrier_post(unsigned* bar, volatile LAS unsigned* st) {
    XcdBarrier b; b.bar = bar; b.x = xb_xcc_id(); b.st = st;
    if (threadIdx.x == 0) (void)xb_add(&bar[XB_XCNT(b.x)], 1u);
    return b;
}
__device__ __forceinline__ void xcd_barrier_complete(unsigned* bar, unsigned x, unsigned& nloc, unsigned& nx) {
    const unsigned G = gridDim.x * gridDim.y * gridDim.z;
    unsigned sum, cnt, mine, sp = 0u;
    for (;;) {
        sum = 0u; cnt = 0u; mine = 0u;
#pragma unroll
        for (unsigned j = 0; j < 16; ++j) { const unsigned c = xb_ld(&bar[XB_XCNT(j)]); sum += c; cnt += (c > 0u) ? 1u : 0u; mine = (j == x) ? c : mine; }
        if (sum == G) break;
        __builtin_amdgcn_s_sleep(1);
        if ((++sp & 255u) == 0u) { if (xb_ld(&bar[XB_TMO])) break; if (sp > XB_SPIN_CAP) { atomicAdd(&bar[XB_TMO], 1u); break; } }
    }
    nloc = mine > 0u ? mine : 1u; nx = cnt > 0u ? cnt : 1u;
}
__device__ __forceinline__ void xcd_barrier(const XcdBarrier& b) {
    asm volatile("s_waitcnt vmcnt(0)" ::: "memory");
    __syncthreads();
    if (threadIdx.x == 0) {
        unsigned* bar = b.bar;
        __builtin_amdgcn_s_waitcnt(0);
        unsigned nloc = b.st[0], nx = b.st[1];
        if (nloc == 0u) { xcd_barrier_complete(bar, b.x, nloc, nx); b.st[0] = nloc; b.st[1] = nx; }
        const unsigned old = xb_add(&bar[XB_XSUB(b.x)], 1u);
        const unsigned gen = old / nloc;
        if (old + 1u == (gen + 1u) * nloc) {
            __builtin_amdgcn_fence(__ATOMIC_RELEASE, "agent");
            asm volatile("s_waitcnt vmcnt(0)" ::: "memory");
            const unsigned og = xb_add(&bar[XB_TOP], 1u);
            const unsigned tg = og / nx;
            if (og + 1u == (tg + 1u) * nx) xb_add(&bar[XB_TOPGEN], 1u);
            else XB_SPIN(xb_ld(&bar[XB_TOPGEN]) == tg, bar);
            __builtin_amdgcn_fence(__ATOMIC_ACQUIRE, "agent");
            xb_add(&bar[XB_XGEN(b.x)], 1u);
            asm volatile("s_waitcnt vmcnt(0)" ::: "memory");
        } else {
            XB_SPIN(xb_ld(&bar[XB_XGEN(b.x)]) == gen, bar);
            __builtin_amdgcn_fence(__ATOMIC_ACQUIRE, "agent");
            asm volatile("s_waitcnt vmcnt(0)" ::: "memory");
        }
    }
    __syncthreads();
}

namespace pg8 {
constexpr int BM = 256, BK = 64, HALF = 128, HTB = HALF * BK * 2, STAGE_BYTES = 8 * HTB, NXCD = 8, WGM = 8;
__host__ __device__ __forceinline__ int lds_byte(int r, int c) { const int st = (r >> 4) * 2 + (c >> 5), rr = r & 15, cc = c & 31, ob = rr * 64 + cc * 2; return st * 1024 + (ob ^ (((ob >> 9) & 1) << 5)); }
__host__ __device__ __forceinline__ void stage_rc(int b, int& R, int& C) { const int st = b / 1024, sb = b % 1024, swz = sb ^ (((sb >> 9) & 1) << 5); R = (st >> 1) * 16 + swz / 64; C = (st & 1) * 32 + (swz % 64) / 2; }
__host__ __device__ __forceinline__ int perm32(int rho) { const int n = rho >> 4, i = rho & 15; return 8 * (i >> 2) + 4 * n + (i & 3); }
struct Unit { int pm, pn; };
struct Gemm { const bf16_t* A; const bf16_t* Bt; int M, N, K, lda, ldb; };
struct StaticOrder {
    int nM, nN, nwg, G, c;
    __host__ __device__ void init(int M_, int N_, int G_, int c_) { nM = M_ / BM; nN = N_ / BM; nwg = nM * nN; G = G_; c = c_; }
    __host__ __device__ bool next(int i, Unit& u) const {
        const long L = (long)i * G + c; if (L >= nwg) return false;
        int wgid = (int)L; { const int q = nwg / NXCD, r = nwg % NXCD, xcd = wgid % NXCD, off = wgid / NXCD; wgid = (xcd < r ? xcd * (q + 1) : r * (q + 1) + (xcd - r) * q) + off; }
        const int nig = WGM * nN, gid = wgid / nig, fm = gid * WGM, gsz = (nM - fm) < WGM ? (nM - fm) : WGM;
        u.pm = fm + ((wgid % nig) % gsz); u.pn = (wgid % nig) / gsz; return true;
    }
};
template <class Epi, bool ALIGN_EPI>
__device__ __forceinline__ void gemm_phase(LAS unsigned char* lds, const Gemm g, const StaticOrder& S, const Epi& E) {
    const int tid = threadIdx.x, wid = __builtin_amdgcn_readfirstlane(tid >> 6), lane = tid & 63, wr = wid >> 2, wc = wid & 3, fr = lane & 15, fq = lane >> 4;
    const int K = g.K, nt = K / BK;
    unsigned voffA[2], voffB[2];
#pragma unroll
    for (int i = 0; i < 2; ++i) { int R, C; stage_rc(tid * 16 + i * 8192, R, C); const int Rb = (R & ~31) + perm32(R & 31);
        voffA[i] = (unsigned)(R * g.lda + C) * 2u; voffB[i] = (unsigned)(Rb * g.ldb + C) * 2u; }
    const size_t kstep = (size_t)(BK * 2);
    const size_t hstepA = (size_t)HALF * g.lda * 2, hstepB = (size_t)HALF * g.ldb * 2;
    const size_t tstepA = 2 * hstepA, tstepB = 2 * hstepB;
    const unsigned ldsw = (unsigned)wid * 1024u;
    const int aoff = lds_byte(wr * 64 + fr, fq * 8), boff = lds_byte(wc * 32 + fr, fq * 8);
#define PG8_SA(b, h) (((b) * 2 + (h)) * HTB)
#define PG8_SB(b, h) ((4 + (b) * 2 + (h)) * HTB)
#define PG8_STAGE(bufoff, gbase, voff) do { _Pragma("unroll") for (int _i = 0; _i < 2; ++_i) \
        __builtin_amdgcn_global_load_lds((const unsigned*)((const char*)(gbase) + (voff)[_i]), (LAS unsigned*)(lds + (bufoff) + ldsw + _i * 8192), 16, 0, 0); } while (0)
#define PG8_LDA(dst, b, h) do { _Pragma("unroll") for (int m = 0; m < 4; ++m) _Pragma("unroll") for (int k = 0; k < 2; ++k) dst[m][k] = *(const LAS bf16x8*)(lds + PG8_SA(b, h) + aoff + m * 2048 + k * 1024); } while (0)
#define PG8_LDB(dst, b, h) do { _Pragma("unroll") for (int n = 0; n < 2; ++n) _Pragma("unroll") for (int k = 0; k < 2; ++k) dst[n][k] = *(const LAS bf16x8*)(lds + PG8_SB(b, h) + boff + n * 2048 + k * 1024); } while (0)
#define PG8_MMA(ai, bj, At, Bt) do { __builtin_amdgcn_s_setprio(1); _Pragma("unroll") for (int m = 0; m < 4; ++m) _Pragma("unroll") for (int n = 0; n < 2; ++n) _Pragma("unroll") for (int k = 0; k < 2; ++k) \
        acc[ai][bj][m][n] = __builtin_amdgcn_mfma_f32_16x16x32_bf16(Bt[n][k], At[m][k], acc[ai][bj][m][n], 0, 0, 0); __builtin_amdgcn_s_setprio(0); } while (0)
#define PG8_WAIT_V(n) asm volatile("s_waitcnt vmcnt(" #n ")" ::: "memory")
#define PG8_WAIT_L(n) asm volatile("s_waitcnt lgkmcnt(" #n ")" ::: "memory")
#define PG8_BAR __builtin_amdgcn_s_barrier()
#define PG8_SCHED __builtin_amdgcn_sched_barrier(0)
    Unit cur, nxt; int ui = 0;
    if (!S.next(0, cur)) return;
    f32x4 acc[2][2][4][2];
#pragma unroll
    for (int a = 0; a < 2; ++a)
#pragma unroll
        for (int b = 0; b < 2; ++b)
#pragma unroll
            for (int m = 0; m < 4; ++m)
#pragma unroll
                for (int n = 0; n < 2; ++n) acc[a][b][m][n] = (f32x4){0.f, 0.f, 0.f, 0.f};
    bf16x8 At[4][2], B0[2][2], B1[2][2];
    const char* cA = (const char*)g.A + (size_t)cur.pm * tstepA; const char* cB = (const char*)g.Bt + (size_t)cur.pn * tstepB;
    PG8_STAGE(PG8_SB(0, 0), cB, voffB); PG8_STAGE(PG8_SB(0, 1), cB + hstepB, voffB); PG8_STAGE(PG8_SA(0, 0), cA, voffA); PG8_STAGE(PG8_SA(0, 1), cA + hstepA, voffA);
    if (wr == 1) PG8_BAR;
    PG8_WAIT_V(2); PG8_BAR;
    PG8_STAGE(PG8_SB(1, 0), cB + kstep, voffB); PG8_STAGE(PG8_SA(1, 0), cA + kstep, voffA); PG8_STAGE(PG8_SB(1, 1), cB + hstepB + kstep, voffB);
    PG8_WAIT_V(6); PG8_BAR;
    for (;;) {
        const bool has_next = S.next(ui + 1, nxt);
        const char* nA = has_next ? (const char*)g.A + (size_t)nxt.pm * tstepA : cA; const char* nB = has_next ? (const char*)g.Bt + (size_t)nxt.pn * tstepB : cB;
        for (int t = 0; t < nt; t += 2) {
            const bool last = (t == nt - 2);
            const char* a1 = cA + (size_t)(t + 1) * kstep;
            const char* a2 = last ? nA : cA + (size_t)(t + 2) * kstep; const char* b2 = last ? nB : cB + (size_t)(t + 2) * kstep;
            const char* a3 = a2 + kstep; const char* b3 = b2 + kstep;
            PG8_LDB(B0, 0, 0); PG8_LDB(B1, 0, 1); PG8_SCHED; PG8_LDA(At, 0, 0); PG8_STAGE(PG8_SA(1, 1), a1 + hstepA, voffA);
            PG8_WAIT_V(8); PG8_WAIT_L(0); PG8_BAR; PG8_MMA(0, 0, At, B0); PG8_MMA(0, 1, At, B1); PG8_BAR; PG8_SCHED;
            PG8_LDA(At, 0, 1); PG8_STAGE(PG8_SB(0, 0), b2, voffB); PG8_STAGE(PG8_SB(0, 1), b2 + hstepB, voffB); PG8_STAGE(PG8_SA(0, 0), a2, voffA);
            PG8_WAIT_V(8); PG8_WAIT_L(0); PG8_BAR; PG8_MMA(1, 0, At, B0); PG8_MMA(1, 1, At, B1); PG8_BAR; PG8_SCHED;
            PG8_LDB(B0, 1, 0); PG8_LDB(B1, 1, 1); PG8_SCHED; PG8_LDA(At, 1, 0); PG8_STAGE(PG8_SA(0, 1), a2 + hstepA, voffA);
            PG8_WAIT_V(8); PG8_WAIT_L(0); PG8_BAR; PG8_MMA(0, 0, At, B0); PG8_MMA(0, 1, At, B1); PG8_BAR; PG8_SCHED;
            PG8_LDA(At, 1, 1); PG8_STAGE(PG8_SB(1, 0), b3, voffB); PG8_STAGE(PG8_SB(1, 1), b3 + hstepB, voffB); PG8_STAGE(PG8_SA(1, 0), a3, voffA);
            PG8_WAIT_V(8); PG8_WAIT_L(0); PG8_BAR; PG8_MMA(1, 0, At, B0); PG8_MMA(1, 1, At, B1); PG8_BAR; PG8_SCHED;
        }
        if constexpr (ALIGN_EPI) { if (wr == 0) PG8_BAR; }
        E(acc, cur, wid, wr, wc, fr, fq);
        if (!has_next) break;
#pragma unroll
        for (int a = 0; a < 2; ++a)
#pragma unroll
            for (int b = 0; b < 2; ++b)
#pragma unroll
                for (int m = 0; m < 4; ++m)
#pragma unroll
                    for (int n = 0; n < 2; ++n) acc[a][b][m][n] = (f32x4){0.f, 0.f, 0.f, 0.f};
        cur = nxt; cA = nA; cB = nB; ++ui;
        if constexpr (ALIGN_EPI) { if (wr == 1) PG8_BAR; }
    }
    PG8_WAIT_V(0);
    if constexpr (!ALIGN_EPI) { if (wr == 0) PG8_BAR; }
    PG8_BAR;
#undef PG8_SA
#undef PG8_SB
#undef PG8_STAGE
#undef PG8_LDA
#undef PG8_LDB
#undef PG8_MMA
#undef PG8_WAIT_V
#undef PG8_WAIT_L
#undef PG8_BAR
#undef PG8_SCHED
}

typedef const f32x4 (&AccRef)[2][2][4][2];
__device__ __forceinline__ float row_rs(const float* ss, int row) {
    const float s = (ss[row] + ss[M + row]) + (ss[2 * M + row] + ss[3 * M + row]);
    return __builtin_amdgcn_rsqf(s * (1.0f / D) + EPS);
}
struct EpiSwiGLU {
    bf16_t* act; const float* ss;
    __device__ __forceinline__ void operator()(AccRef acc, const Unit& u, int wid, int wr, int wc, int fr, int fq) const {
        const int row0 = u.pm * BM + wr * 64 + fr, col0 = u.pn * HALF + wc * 32 + 8 * fq;
#pragma unroll
        for (int ai = 0; ai < 2; ++ai)
#pragma unroll
            for (int m = 0; m < 4; ++m) {
                const int row = row0 + ai * HALF + m * 16; const float r = row_rs(ss, row); float o[8];
#pragma unroll
                for (int n = 0; n < 2; ++n)
#pragma unroll
                    for (int j = 0; j < 4; ++j) { const float gt = acc[ai][0][m][n][j] * r, up = acc[ai][1][m][n][j] * r; o[n * 4 + j] = gt * fast_sigmoid(gt) * up; }
                u32x4 w; w.x = cvt_pk_bf16(o[0], o[1]); w.y = cvt_pk_bf16(o[2], o[3]); w.z = cvt_pk_bf16(o[4], o[5]); w.w = cvt_pk_bf16(o[6], o[7]);
                *(u32x4*)(act + (size_t)row * DFF + col0) = w;
            }
    }
};
struct EpiResid {
    const float* base; float* out; bf16_t* hb; float* ss; float alpha; LAS float* P;
    __device__ __forceinline__ void operator()(AccRef acc, const Unit& u, int wid, int wr, int wc, int fr, int fq) const {
        const int rl0 = wr * 64 + fr, col0 = u.pn * BM + wc * 32 + 8 * fq;
#pragma unroll
        for (int ai = 0; ai < 2; ++ai)
#pragma unroll
            for (int m = 0; m < 4; ++m) {
                const int rl = rl0 + ai * HALF + m * 16; const size_t off = (size_t)(u.pm * BM + rl) * D + col0; float s = 0.f;
#pragma unroll
                for (int bj = 0; bj < 2; ++bj) {
                    const f32x4 b0 = *(const f32x4*)(base + off + bj * HALF), b1 = *(const f32x4*)(base + off + bj * HALF + 4);
                    const f32x4 v0 = b0 + acc[ai][bj][m][0] * alpha, v1 = b1 + acc[ai][bj][m][1] * alpha;
                    *(f32x4*)(out + off + bj * HALF) = v0; *(f32x4*)(out + off + bj * HALF + 4) = v1;
                    if (hb) { u32x4 w; w.x = cvt_pk_bf16(v0[0], v0[1]); w.y = cvt_pk_bf16(v0[2], v0[3]); w.z = cvt_pk_bf16(v1[0], v1[1]); w.w = cvt_pk_bf16(v1[2], v1[3]); *(u32x4*)(hb + off + bj * HALF) = w; }
                    s += (v0[0] * v0[0] + v0[1] * v0[1]) + (v0[2] * v0[2] + v0[3] * v0[3]) + (v1[0] * v1[0] + v1[1] * v1[1]) + (v1[2] * v1[2] + v1[3] * v1[3]);
                }
                s += __shfl_xor(s, 16); s += __shfl_xor(s, 32);
                if (fq == 0) P[rl * 4 + wc] = s;
            }
        asm volatile("s_waitcnt lgkmcnt(0)" ::: "memory"); __builtin_amdgcn_s_barrier(); asm volatile("" ::: "memory");
        const int t = threadIdx.x;
        if (t < 256) { const f32x4 p = *(const LAS f32x4*)(P + t * 4); ss[(size_t)u.pn * M + u.pm * BM + t] = (p[0] + p[1]) + (p[2] + p[3]); }
    }
};
struct EpiWin {
    bf16_t* z; float* zif; const float* bias; const float* ss;
    __device__ __forceinline__ void operator()(AccRef acc, const Unit& u, int wid, int wr, int wc, int fr, int fq) const {
        const int row0 = u.pm * BM + wr * 64 + fr, col0 = u.pn * BM + wc * 32 + 8 * fq;
        if (u.pn == 18) {
            if (wc == 0 && fq == 0) {
                const f32x4 bi = *(const f32x4*)(bias + ZW), bf = *(const f32x4*)(bias + ZW + 4);
#pragma unroll
                for (int ai = 0; ai < 2; ++ai)
#pragma unroll
                    for (int m = 0; m < 4; ++m) {
                        const int row = row0 + ai * HALF + m * 16; const float r = row_rs(ss, row);
                        const f32x4 vi = acc[ai][0][m][0] * r + bi, vf = acc[ai][0][m][1] * r + bf; f32x4 lf;
#pragma unroll
                        for (int j = 0; j < 4; ++j) { const float x = vf[j]; lf[j] = fminf(x, 0.f) - __logf(1.0f + __expf(-fabsf(x))); }
                        *(f32x4*)(zif + (size_t)row * 8) = vi; *(f32x4*)(zif + (size_t)row * 8 + 4) = lf;
                    }
            }
            return;
        }
        const bool sg = (u.pn == 6) | (u.pn == 7) | (u.pn >= 10);
        f32x4 bv[2][2];
#pragma unroll
        for (int bj = 0; bj < 2; ++bj)
#pragma unroll
            for (int n = 0; n < 2; ++n) bv[bj][n] = *(const f32x4*)(bias + col0 + bj * HALF + 4 * n);
#pragma unroll
        for (int ai = 0; ai < 2; ++ai)
#pragma unroll
            for (int m = 0; m < 4; ++m) {
                const int row = row0 + ai * HALF + m * 16; const float r = row_rs(ss, row);
#pragma unroll
                for (int bj = 0; bj < 2; ++bj) {
                    f32x4 v0 = acc[ai][bj][m][0] * r + bv[bj][0], v1 = acc[ai][bj][m][1] * r + bv[bj][1];
                    if (sg) {
#pragma unroll
                        for (int j = 0; j < 4; ++j) { v0[j] = fast_sigmoid(v0[j]); v1[j] = fast_sigmoid(v1[j]); } }
                    u32x4 w; w.x = cvt_pk_bf16(v0[0], v0[1]); w.y = cvt_pk_bf16(v0[2], v0[3]); w.z = cvt_pk_bf16(v1[0], v1[1]); w.w = cvt_pk_bf16(v1[2], v1[3]);
                    *(u32x4*)(z + (size_t)row * ZW + col0 + bj * HALF) = w;
                }
            }
    }
};
template <bool ADD> struct EpiMerge {
    bf16_t* mg; const bf16_t* z; int gcol0;
    __device__ __forceinline__ void operator()(AccRef acc, const Unit& u, int wid, int wr, int wc, int fr, int fq) const {
        const int row0 = u.pm * BM + wr * 64 + fr, col0 = u.pn * BM + wc * 32 + 8 * fq;
#pragma unroll
        for (int ai = 0; ai < 2; ++ai)
#pragma unroll
            for (int m = 0; m < 4; ++m) {
                const int row = row0 + ai * HALF + m * 16;
#pragma unroll
                for (int bj = 0; bj < 2; ++bj) {
                    const u32x4 gt = *(const u32x4*)(z + (size_t)row * ZW + gcol0 + col0 + bj * HALF);
                    bf16_t* mp = mg + (size_t)row * D + col0 + bj * HALF;
                    f32x4 v0 = acc[ai][bj][m][0], v1 = acc[ai][bj][m][1];
                    v0[0] *= bf_lo(gt.x); v0[1] *= bf_hi(gt.x); v0[2] *= bf_lo(gt.y); v0[3] *= bf_hi(gt.y);
                    v1[0] *= bf_lo(gt.z); v1[1] *= bf_hi(gt.z); v1[2] *= bf_lo(gt.w); v1[3] *= bf_hi(gt.w);
                    if (ADD) { const u32x4 pv = *(const u32x4*)mp;
                        v0[0] += bf_lo(pv.x); v0[1] += bf_hi(pv.x); v0[2] += bf_lo(pv.y); v0[3] += bf_hi(pv.y);
                        v1[0] += bf_lo(pv.z); v1[1] += bf_hi(pv.z); v1[2] += bf_lo(pv.w); v1[3] += bf_hi(pv.w); }
                    u32x4 w; w.x = cvt_pk_bf16(v0[0], v0[1]); w.y = cvt_pk_bf16(v0[2], v0[3]); w.z = cvt_pk_bf16(v1[0], v1[1]); w.w = cvt_pk_bf16(v1[2], v1[3]);
                    *(u32x4*)mp = w;
                }
            }
    }
};
}

struct Args {
    const float* x; const float* n1g; const float* wgu1; const float* wdn1; const float* mng; const float* win; const float* bin; const float* convw;
    const float* hng; const float* pa; const float* wpool; const float* pscale; const float* pb; const float* wout; const float* n2g; const float* wgu2; const float* wdn2; const float* fng;
    float* out; unsigned char* ws; int ph_lo, ph_hi;
};

__device__ __forceinline__ float wave_sum(float v) {
#pragma unroll
    for (int o = 1; o < 64; o <<= 1) v += __shfl_xor(v, o);
    return v;
}
__device__ __forceinline__ float wave_max(float v) {
#pragma unroll
    for (int o = 1; o < 64; o <<= 1) v = fmaxf(v, __shfl_xor(v, o));
    return v;
}
__device__ __forceinline__ void transpose_item(const float* W, int N, int nvalid, const float* gain, bf16_t* WT, int ldt, int k0, int n0, int drow0, LAS float* scr, int lane) {
#pragma unroll 8
    for (int i = 0; i < 32; ++i) { const int kk = 2 * i + (lane >> 5), n = n0 + (lane & 31);
        float v = 0.f; if (n < nvalid) { v = W[(size_t)(k0 + kk) * N + n]; if (gain) v *= gain[k0 + kk]; }
        scr[kk * 33 + (lane & 31)] = v; }
    asm volatile("s_waitcnt lgkmcnt(0)" ::: "memory");
    const int c = lane & 7;
#pragma unroll
    for (int j = 0; j < 4; ++j) { const int n = (lane >> 3) + 8 * j; const LAS float* s = scr + (8 * c) * 33 + n;
        u32x4 o; o.x = cvt_pk_bf16(s[0 * 33], s[1 * 33]); o.y = cvt_pk_bf16(s[2 * 33], s[3 * 33]); o.z = cvt_pk_bf16(s[4 * 33], s[5 * 33]); o.w = cvt_pk_bf16(s[6 * 33], s[7 * 33]);
        *(u32x4*)(WT + (size_t)(drow0 + n) * ldt + k0 + 8 * c) = o; }
    asm volatile("s_waitcnt lgkmcnt(0)" ::: "memory");
}
__device__ __forceinline__ int gu_row(int n0) {
    const int isup = n0 >= DFF, nn = isup ? n0 - DFF : n0; return 256 * (nn >> 7) + (isup ? 128 : 0) + (nn & 127);
}

__device__ __forceinline__ void p0_prologue(const Args& a, LAS unsigned char* lds, int gw, int NGW, int lane, int wave) {
    unsigned char* ws = a.ws;
    LAS float* scr = (LAS float*)(lds + wave * 16384);
    constexpr int I_GU = (D / 64) * (NGU / 32), I_DN = (DFF / 64) * (D / 32), I_IN = (D / 64) * (NIN / 32), I_PA = (512 / 64) * (D / 32), I_WO = (D / 64) * (D / 32);
    constexpr int NITEMS = 2 * I_GU + 2 * I_DN + I_IN + I_PA + I_WO;
    for (int it = gw; it < NITEMS; it += NGW) {
        int r = it;
        if (r < I_GU) { const int nb = r % (NGU / 32), kb = r / (NGU / 32); transpose_item(a.wgu1, NGU, NGU, a.n1g, (bf16_t*)(ws + WS_WGU1), D, kb * 64, nb * 32, gu_row(nb * 32) - 0, scr, lane); continue; } r -= I_GU;
        if (r < I_GU) { const int nb = r % (NGU / 32), kb = r / (NGU / 32); transpose_item(a.wgu2, NGU, NGU, a.n2g, (bf16_t*)(ws + WS_WGU2), D, kb * 64, nb * 32, gu_row(nb * 32) - 0, scr, lane); continue; } r -= I_GU;
        if (r < I_DN) { const int nb = r % (D / 32), kb = r / (D / 32); transpose_item(a.wdn1, D, D, nullptr, (bf16_t*)(ws + WS_WDN1), DFF, kb * 64, nb * 32, nb * 32, scr, lane); continue; } r -= I_DN;
        if (r < I_DN) { const int nb = r % (D / 32), kb = r / (D / 32); transpose_item(a.wdn2, D, D, nullptr, (bf16_t*)(ws + WS_WDN2), DFF, kb * 64, nb * 32, nb * 32, scr, lane); continue; } r -= I_DN;
        if (r < I_IN) { const int nb = r % (NIN / 32), kb = r / (NIN / 32); transpose_item(a.win, DIN, DIN, a.mng, (bf16_t*)(ws + WS_WIN), D, kb * 64, nb * 32, nb * 32, scr, lane); continue; } r -= I_IN;
        if (r < I_PA) { const int nb = r % (D / 32), kb = r / (D / 32); transpose_item(a.pa, D, D, nullptr, (bf16_t*)(ws + WS_WAB), D, kb * 64, nb * 32, nb * 32, scr, lane); continue; } r -= I_PA;
        { const int nb = r % (D / 32), kb = r / (D / 32); transpose_item(a.wout, D, D, nullptr, (bf16_t*)(ws + WS_WOUT), D, kb * 64, nb * 32, nb * 32, scr, lane); }
    }
    {
        bf16_t* wab = (bf16_t*)(ws + WS_WAB);
        const int gt = gw * 64 + lane, NT = NGW * 64;
        for (int o = gt; o < 512 * D; o += NT) {
            const int n = o & (D - 1), kk = o >> 10, g = kk >> 7;
            const float* wp = a.wpool + (size_t)kk * 128; const float* ps = a.pscale + g * 128; const float* pb = a.pb + (size_t)(g * 128) * D + n;
            float s = 0.f;
#pragma unroll 8
            for (int d = 0; d < 128; ++d) s += wp[d] * ps[d] * pb[(size_t)d * D];
            wab[(size_t)n * D + 512 + kk] = (bf16_t)(cvt_pk_bf16(s, 0.f) & 0xffffu);
        }
    }
    {
        bf16_t* hb = (bf16_t*)(ws + WS_H); float* ss = (float*)(ws + WS_SS);
        for (int m = gw; m < M; m += NGW) {
            const f32x4* xr = (const f32x4*)(a.x + (size_t)m * D) + lane; f32x4 v[4]; float s = 0.f;
#pragma unroll
            for (int j = 0; j < 4; ++j) { v[j] = xr[64 * j]; s += (v[j][0] * v[j][0] + v[j][1] * v[j][1]) + (v[j][2] * v[j][2] + v[j][3] * v[j][3]); }
            s = wave_sum(s);
            u32x2* o8 = (u32x2*)(hb + (size_t)m * D) + lane;
#pragma unroll
            for (int j = 0; j < 4; ++j) { u32x2 w; w.x = cvt_pk_bf16(v[j][0], v[j][1]); w.y = cvt_pk_bf16(v[j][2], v[j][3]); o8[64 * j] = w; }
            if (lane < 4) ss[(size_t)lane * M + m] = lane == 0 ? s : 0.f;
        }
    }
}

constexpr int QP = 136, TP = 72;
__device__ __forceinline__ bf16x8 ldfrag(const LAS bf16_t* base, int pitch, int row, int kofs) { return *(const LAS bf16x8*)(base + row * pitch + kofs); }
__device__ __forceinline__ float silu_f(float x) { return x * fast_sigmoid(x); }

__device__ __forceinline__ void conv8(const bf16_t* z, const float* cw, int r0, int s, int seq0, int col, float (&o)[8]) {
#pragma unroll
    for (int e = 0; e < 8; ++e) o[e] = 0.f;
#pragma unroll
    for (int j = 0; j < 4; ++j) {
        const int t = s - 3 + j;
        if (seq0 + t >= 0) {
            const u32x4 v = *(const u32x4*)(z + (size_t)(r0 + t) * ZW + col);
            const f32x4 w0 = *(const f32x4*)(cw + j * 1024 + col), w1 = *(const f32x4*)(cw + j * 1024 + col + 4);
            o[0] += w0[0] * bf_lo(v.x); o[1] += w0[1] * bf_hi(v.x); o[2] += w0[2] * bf_lo(v.y); o[3] += w0[3] * bf_hi(v.y);
            o[4] += w1[0] * bf_lo(v.z); o[5] += w1[1] * bf_hi(v.z); o[6] += w1[2] * bf_lo(v.w); o[7] += w1[3] * bf_hi(v.w);
        }
    }
#pragma unroll
    for (int e = 0; e < 8; ++e) o[e] = silu_f(o[e]);
}

__device__ __forceinline__ void p4_unit(const Args& a, LAS unsigned char* lds, int u) {
    unsigned char* ws = a.ws;
    const bf16_t* z = (const bf16_t*)(ws + WS_Z); const float* zif = (const float*)(ws + WS_ZIF);
    const int tid = threadIdx.x, lane = tid & 63, wave = tid >> 6, fr = lane & 15, fq = lane >> 4;
    const int h = u & 3, c = (u >> 2) & (NCH - 1), b = u >> 9, r0 = b * SEQ + c * CH, seq0 = c * CH;
    LAS bf16_t* KT = (LAS bf16_t*)lds;
    LAS bf16_t* VT = KT + 128 * TP;
    LAS float* sW = (LAS float*)(VT + 128 * TP);
    LAS float* sKf = sW + 64;
    if (wave == 0) {
        const float lf = zif[(size_t)(r0 + lane) * 8 + 4 + h], ig = zif[(size_t)(r0 + lane) * 8 + h];
        float bc = lf;
#pragma unroll
        for (int o = 1; o < 64; o <<= 1) { const float t = __shfl_up(bc, o); if (lane >= o) bc += t; }
        const float Bt = __shfl(bc, 63), g = Bt - bc + ig, ml = wave_max(g);
        sW[lane] = __expf(g - ml);
        if (lane == 0) { ((float*)(ws + WS_UB))[u] = Bt; ((float*)(ws + WS_UM))[u] = ml; }
    }
    __syncthreads();
    {
        const int s = tid & 63;
#pragma unroll
        for (int it = 0; it < 2; ++it) { const int dg = (tid >> 6) + 8 * it; float o[8];
            conv8(z, a.convw, r0, s, seq0, ZC_K + h * DH + dg * 8, o);
#pragma unroll
            for (int e = 0; e < 8; ++e) { const float kv = o[e] * 0.08838834764831845f; KT[(dg * 8 + e) * TP + s] = (bf16_t)(cvt_pk_bf16(kv, 0.f) & 0xffffu); sKf[s * 132 + dg * 8 + e] = kv; } }
        const float w = sW[s];
#pragma unroll
        for (int it = 0; it < 2; ++it) { const int vg = (tid >> 6) + 8 * it;
            const u32x4 v = *(const u32x4*)(z + (size_t)(r0 + s) * ZW + ZC_V + h * DH + vg * 8);
            const float f[8] = {bf_lo(v.x), bf_hi(v.x), bf_lo(v.y), bf_hi(v.y), bf_lo(v.z), bf_hi(v.z), bf_lo(v.w), bf_hi(v.w)};
#pragma unroll
            for (int e = 0; e < 8; ++e) VT[(vg * 8 + e) * TP + s] = (bf16_t)(cvt_pk_bf16(f[e] * w, 0.f) & 0xffffu); }
    }
    __syncthreads();
    {
        bf16_t* cst = (bf16_t*)(ws + WS_H) + (size_t)u * DH * DH;
        const int v0 = wave * 16;
        const bf16x8 bv0 = ldfrag(VT, TP, v0 + fr, 8 * fq), bv1 = ldfrag(VT, TP, v0 + fr, 32 + 8 * fq);
#pragma unroll
        for (int dt = 0; dt < 8; ++dt) {
            const bf16x8 a0 = ldfrag(KT, TP, dt * 16 + fr, 8 * fq), a1 = ldfrag(KT, TP, dt * 16 + fr, 32 + 8 * fq);
            f32x4 acc = {0.f, 0.f, 0.f, 0.f};
            acc = __builtin_amdgcn_mfma_f32_16x16x32_bf16(a0, bv0, acc, 0, 0, 0);
            acc = __builtin_amdgcn_mfma_f32_16x16x32_bf16(a1, bv1, acc, 0, 0, 0);
            u32x2 w; w.x = cvt_pk_bf16(acc[0], acc[1]); w.y = cvt_pk_bf16(acc[2], acc[3]);
#if P4_SYNTH
            { const float base = (float)((v0 + fr) * 128 + dt * 16 + 4 * fq) * 1e-5f * (float)(1 + (u % 7)); w.x = cvt_pk_bf16(base, base + 1e-5f); w.y = cvt_pk_bf16(base + 2e-5f, base + 3e-5f); }
#endif
            *(u32x2*)(cst + (size_t)(v0 + fr) * DH + dt * 16 + 4 * fq) = w;
        }
        if (tid < 128) { float s = 0.f;
#pragma unroll 8
            for (int k = 0; k < 64; ++k) s += sW[k] * sKf[k * 132 + tid];
            ((float*)(ws + WS_NST))[(size_t)u * DH + tid] = s; }
    }
    {
        bf16_t* a2 = (bf16_t*)(ws + WS_A2); const int win = 2 << h;
#pragma unroll
        for (int it = 0; it < 2; ++it) { const int idx = tid + 512 * it, s = idx >> 4, cg = idx & 15, pos = seq0 + s; const int cnt = pos + 1 < win ? pos + 1 : win;
            float sum[8], cur[8];
#pragma unroll
            for (int e = 0; e < 8; ++e) sum[e] = 0.f;
            for (int j = 0; j < cnt; ++j) { const u32x4 v = *(const u32x4*)(z + (size_t)(r0 + s - j) * ZW + ZC_U + h * 128 + cg * 8);
                const float f[8] = {bf_lo(v.x), bf_hi(v.x), bf_lo(v.y), bf_hi(v.y), bf_lo(v.z), bf_hi(v.z), bf_lo(v.w), bf_hi(v.w)};
#pragma unroll
                for (int e = 0; e < 8; ++e) { sum[e] += f[e]; if (j == 0) cur[e] = f[e]; } }
            const float inv = 1.0f / (float)cnt;
            u32x4 w; w.x = cvt_pk_bf16(sum[0] * inv - cur[0], sum[1] * inv - cur[1]); w.y = cvt_pk_bf16(sum[2] * inv - cur[2], sum[3] * inv - cur[3]);
            w.z = cvt_pk_bf16(sum[4] * inv - cur[4], sum[5] * inv - cur[5]); w.w = cvt_pk_bf16(sum[6] * inv - cur[6], sum[7] * inv - cur[7]);
            *(u32x4*)(a2 + (size_t)(r0 + s) * D + 512 + h * 128 + cg * 8) = w; }
    }
    __syncthreads();
}

__device__ __forceinline__ void p5_scan(const Args& a, int wg) {
    unsigned char* ws = a.ws;
    const int tid = threadIdx.x, stream = wg >> 3, slice = wg & 7, b = stream >> 2, h = stream & 3;
    const float* uB = (const float*)(ws + WS_UB); const float* uM = (const float*)(ws + WS_UM); float* uMS = (float*)(ws + WS_UMS);
    const bf16_t* dcs = (const bf16_t*)(ws + WS_H); const float* dns = (const float*)(ws + WS_NST);
    bf16_t* cst = (bf16_t*)(ws + WS_CST); float* nst = (float*)(ws + WS_NST2);
    const int eoff = (slice * 16 + (tid >> 5)) * DH + (tid & 31) * 4;
    float C0 = 0.f, C1 = 0.f, C2 = 0.f, C3 = 0.f, nn = 0.f, mst = 0.f;
    const bool do_n = (slice == 0) && (tid < 128);
    constexpr int SB = 8;
    for (int cb = 0; cb < NCH; cb += SB) {
        u32x2 dv[SB]; float dn[SB], Bt[SB], ml[SB];
#pragma unroll
        for (int i = 0; i < SB; ++i) { const int u = ((b * NCH + cb + i) << 2) + h;
            dv[i] = *(const u32x2*)(dcs + (size_t)u * DH * DH + eoff); dn[i] = (do_n && !P5_NODN) ? dns[(size_t)u * DH + tid] : 0.f; Bt[i] = uB[u]; ml[i] = uM[u]; if (P5_CONSTBM) { Bt[i] = -4.5f; ml[i] = 1.0f; } }
#pragma unroll
        for (int i = 0; i < SB; ++i) { const int u = ((b * NCH + cb + i) << 2) + h;
            const float mn = fmaxf(Bt[i] + mst, ml[i]), dec = __expf(Bt[i] + mst - mn), sc = __expf(ml[i] - mn);
            C0 = dec * C0 + sc * bf_lo(dv[i].x); C1 = dec * C1 + sc * bf_hi(dv[i].x); C2 = dec * C2 + sc * bf_lo(dv[i].y); C3 = dec * C3 + sc * bf_hi(dv[i].y);
            nn = dec * nn + sc * dn[i]; mst = mn;
            u32x2 w; w.x = cvt_pk_bf16(C0, C1); w.y = cvt_pk_bf16(C2, C3);
            if (P5_ZERO) { w.x = 0u; w.y = 0u; }
            *(u32x2*)(cst + (size_t)u * DH * DH + eoff) = w;
            if (do_n) nst[(size_t)u * DH + tid] = P5_ZERO ? 0.f : nn;
            if (slice == 0 && tid == 0) uMS[u] = P5_ZERO ? 0.f : mn; }
    }
}

__device__ __forceinline__ void p6_unit(const Args& a, LAS unsigned char* lds, int u) {
    unsigned char* ws = a.ws;
    const bf16_t* z = (const bf16_t*)(ws + WS_Z); const float* zif = (const float*)(ws + WS_ZIF);
    const int tid = threadIdx.x, lane = tid & 63, wave = tid >> 6, fr = lane & 15, fq = lane >> 4;
    const int h = u & 3, c = (u >> 2) & (NCH - 1), b = u >> 9, r0 = b * SEQ + c * CH, seq0 = c * CH;
    LAS bf16_t* Qs = (LAS bf16_t*)lds;
    LAS bf16_t* Ks = Qs + 64 * QP;
    LAS bf16_t* VT = Ks + 64 * QP;
    LAS bf16_t* Cs = VT + 128 * TP;
    LAS bf16_t* Ps = Cs + 128 * QP;
    LAS float* Hs = (LAS float*)(Ps + 64 * TP);
    LAS float* sN = Hs + 64 * 132;
    LAS float* sWi = sN + 128;
    LAS float* sRt = sWi + 64;
    LAS float* sE = sRt + 64;
    LAS float* sFl = sE + 64;
    LAS float* sInv = sFl + 64;
    if (wave == 0) {
        const float lf = zif[(size_t)(r0 + lane) * 8 + 4 + h], ig = zif[(size_t)(r0 + lane) * 8 + h];
        float bc = lf;
#pragma unroll
        for (int o = 1; o < 64; o <<= 1) { const float t = __shfl_up(bc, o); if (lane >= o) bc += t; }
        const float e = ig - bc; float cm = e;
#pragma unroll
        for (int o = 1; o < 64; o <<= 1) { const float t = __shfl_up(cm, o); if (lane >= o) cm = fmaxf(cm, t); }
        const float mprev = (c == 0 || P6_NOSTATE) ? 0.f : ((const float*)(ws + WS_UMS))[u - NH];
        const float ai = bc + mprev, mt = fmaxf(ai, bc + cm);
        sWi[lane] = __expf(ai - mt); sRt[lane] = bc - mt; sE[lane] = e; sFl[lane] = __expf(-mt);
    }
    {
#pragma unroll
        for (int it = 0; it < 2; ++it) { const int idx = tid + 512 * it, s = idx >> 4, dg = idx & 15; float o[8];
            conv8(z, a.convw, r0, s, seq0, ZC_Q + h * DH + dg * 8, o);
            u32x4 w; w.x = cvt_pk_bf16(o[0], o[1]); w.y = cvt_pk_bf16(o[2], o[3]); w.z = cvt_pk_bf16(o[4], o[5]); w.w = cvt_pk_bf16(o[6], o[7]);
            *(LAS u32x4*)(Qs + s * QP + dg * 8) = w;
            conv8(z, a.convw, r0, s, seq0, ZC_K + h * DH + dg * 8, o);
#pragma unroll
            for (int e = 0; e < 8; ++e) o[e] *= 0.08838834764831845f;
            w.x = cvt_pk_bf16(o[0], o[1]); w.y = cvt_pk_bf16(o[2], o[3]); w.z = cvt_pk_bf16(o[4], o[5]); w.w = cvt_pk_bf16(o[6], o[7]);
            *(LAS u32x4*)(Ks + s * QP + dg * 8) = w; }
        const int s = tid & 63;
#pragma unroll
        for (int it = 0; it < 2; ++it) { const int vg = (tid >> 6) + 8 * it;
            const u32x4 v = *(const u32x4*)(z + (size_t)(r0 + s) * ZW + ZC_V + h * DH + vg * 8);
            const unsigned wv[4] = {v.x, v.y, v.z, v.w};
#pragma unroll
            for (int e = 0; e < 4; ++e) { VT[(vg * 8 + 2 * e) * TP + s] = (bf16_t)(wv[e] & 0xffffu); VT[(vg * 8 + 2 * e + 1) * TP + s] = (bf16_t)(wv[e] >> 16); } }
        if (c > 0 && !P6_NOSTATE) {
            const bf16_t* cp = (const bf16_t*)(ws + WS_CST) + (size_t)(u - NH) * DH * DH;
#pragma unroll
            for (int it = 0; it < 4; ++it) { const int idx = tid + 512 * it, v = idx >> 4, dg = idx & 15; u32x4 cv = *(const u32x4*)(cp + v * DH + dg * 8);
#if P6_SANITIZE
#pragma unroll
                for (int q = 0; q < 4; ++q) { unsigned w = cv[q]; if ((w & 0x7f80u) == 0x7f80u) w &= 0xffff0000u; if ((w & 0x7f800000u) == 0x7f800000u) w &= 0x0000ffffu; cv[q] = w; }
#endif
                *(LAS u32x4*)(Cs + v * QP + dg * 8) = cv; }
            if (tid < 128) sN[tid] = ((const float*)(ws + WS_NST2))[(size_t)(u - NH) * DH + tid];
        } else {
#pragma unroll
            for (int it = 0; it < 4; ++it) { const int idx = tid + 512 * it, v = idx >> 4, dg = idx & 15; *(LAS u32x4*)(Cs + v * QP + dg * 8) = (u32x4){0u, 0u, 0u, 0u}; }
            if (tid < 128) sN[tid] = 0.f;
        }
    }
    __syncthreads();
    {
        const int t0 = (wave & 3) * 16;
        bf16x8 qf[4];
#pragma unroll
        for (int kk = 0; kk < 4; ++kk) qf[kk] = ldfrag(Qs, QP, t0 + fr, 32 * kk + 8 * fq);
        const float rt = sRt[t0 + fr]; const int t = t0 + fr;
#pragma unroll
        for (int i2 = 0; i2 < 2; ++i2) { const int s0 = ((wave >> 2) * 2 + i2) * 16;
            f32x4 acc = {0.f, 0.f, 0.f, 0.f};
#pragma unroll
            for (int kk = 0; kk < 4; ++kk) acc = __builtin_amdgcn_mfma_f32_16x16x32_bf16(ldfrag(Ks, QP, s0 + fr, 32 * kk + 8 * fq), qf[kk], acc, 0, 0, 0);
            float p[4];
#pragma unroll
            for (int j = 0; j < 4; ++j) { const int s = s0 + 4 * fq + j; p[j] = s <= t ? acc[j] * __expf(rt + sE[s]) : 0.f; }
            u32x2 w; w.x = cvt_pk_bf16(p[0], p[1]); w.y = cvt_pk_bf16(p[2], p[3]);
            *(LAS u32x2*)(Ps + t * TP + s0 + 4 * fq) = w; }
    }
    __syncthreads();
    {
        const int t = tid >> 3, part = tid & 7; float nq = 0.f, rs = 0.f;
#pragma unroll
        for (int d = 0; d < 16; ++d) nq += sN[part * 16 + d] * __uint_as_float((unsigned)Qs[t * QP + part * 16 + d] << 16);
#pragma unroll
        for (int s = 0; s < 8; ++s) rs += __uint_as_float((unsigned)Ps[t * TP + part * 8 + s] << 16);
        float den = sWi[t] * nq + rs;
        den += __shfl_xor(den, 1); den += __shfl_xor(den, 2); den += __shfl_xor(den, 4);
        if (part == 0) sInv[t] = 1.0f / fmaxf(fabsf(den), sFl[t]);
    }
    __syncthreads();
    {
        const int v0 = wave * 16;
        bf16x8 cf[4], vf[2];
#pragma unroll
        for (int kk = 0; kk < 4; ++kk) cf[kk] = ldfrag(Cs, QP, v0 + fr, 32 * kk + 8 * fq);
#pragma unroll
        for (int kk = 0; kk < 2; ++kk) vf[kk] = ldfrag(VT, TP, v0 + fr, 32 * kk + 8 * fq);
#pragma unroll
        for (int tt = 0; tt < 4; ++tt) { const int t = tt * 16 + fr;
            f32x4 ai = {0.f, 0.f, 0.f, 0.f}, ap = {0.f, 0.f, 0.f, 0.f};
#pragma unroll
            for (int kk = 0; kk < 4; ++kk) ai = __builtin_amdgcn_mfma_f32_16x16x32_bf16(cf[kk], ldfrag(Qs, QP, t, 32 * kk + 8 * fq), ai, 0, 0, 0);
#pragma unroll
            for (int kk = 0; kk < 2; ++kk) ap = __builtin_amdgcn_mfma_f32_16x16x32_bf16(vf[kk], ldfrag(Ps, TP, t, 32 * kk + 8 * fq), ap, 0, 0, 0);
            const float wi = sWi[t], inv = sInv[t];
            *(LAS f32x4*)(Hs + t * 132 + v0 + 4 * fq) = (ai * wi + ap) * inv; }
    }
    __syncthreads();
    {
        bf16_t* a2 = (bf16_t*)(ws + WS_A2); const f32x2 g = *(const f32x2*)(a.hng + h * DH + 2 * lane);
#pragma unroll
        for (int i = 0; i < 8; ++i) { const int t = wave * 8 + i; const f32x2 hv = *(const LAS f32x2*)(Hs + t * 132 + 2 * lane);
            const float ssq = wave_sum(hv[0] * hv[0] + hv[1] * hv[1]), rn = __builtin_amdgcn_rsqf(ssq * (1.0f / DH) + EPS);
            const unsigned so = *(const unsigned*)(z + (size_t)(r0 + t) * ZW + ZC_O + h * DH + 2 * lane);
            *(unsigned*)(a2 + (size_t)(r0 + t) * D + h * DH + 2 * lane) = cvt_pk_bf16(hv[0] * rn * g[0] * bf_lo(so), hv[1] * rn * g[1] * bf_hi(so)); }
    }
    __syncthreads();
}

__device__ __forceinline__ void p_final(const Args& a, int gw, int NGW, int lane) {
    const f32x4* gp = (const f32x4*)a.fng + lane; f32x4 g[4];
#pragma unroll
    for (int j = 0; j < 4; ++j) g[j] = gp[64 * j];
    for (int m = gw; m < M; m += NGW) {
        f32x4* xr = (f32x4*)(a.out + (size_t)m * D) + lane; f32x4 v[4]; float s = 0.f;
#pragma unroll
        for (int j = 0; j < 4; ++j) { v[j] = xr[64 * j]; s += (v[j][0] * v[j][0] + v[j][1] * v[j][1]) + (v[j][2] * v[j][2] + v[j][3] * v[j][3]); }
        const float r = __builtin_amdgcn_rsqf(wave_sum(s) * (1.0f / D) + EPS);
#pragma unroll
        for (int j = 0; j < 4; ++j) xr[64 * j] = v[j] * r * g[j];
    }
}

__global__ void __launch_bounds__(512, 2) fwd_kernel(Args a) {
    extern __shared__ __attribute__((aligned(16))) unsigned char lds_raw[];
    LAS unsigned char* lds = (LAS unsigned char*)lds_raw;
    volatile LAS unsigned* MISC = (volatile LAS unsigned*)(lds + MISC_OFF);
    const int tid = threadIdx.x, lane = tid & 63, wave = __builtin_amdgcn_readfirstlane(tid >> 6);
    const int G = gridDim.x, bx = blockIdx.x;
    const int vcu = (G % 8 == 0) ? (bx % 8) * (G / 8) + bx / 8 : bx;
    const int gw = vcu * 8 + wave, NGW = G * 8;
    unsigned char* ws = a.ws;
    if (tid < 32) MISC[tid] = 0u;
    __syncthreads();
    XcdBarrier bar; bar.bar = (unsigned*)(ws + WS_CTL) + CW_BAR; bar.x = 0; bar.st = nullptr;
    if (MK_N_LAUNCHES == 1) bar = xcd_barrier_post((unsigned*)(ws + WS_CTL) + CW_BAR, MISC + 8);
    const int lo = a.ph_lo, hi = a.ph_hi;
#define IN(k) (lo <= (k) && (k) < hi)
#define SEAM(k) do { if (IN(k) && IN((k) + 1)) xcd_barrier(bar); } while (0)
    bf16_t* const HB = (bf16_t*)(ws + WS_H); bf16_t* const A2 = (bf16_t*)(ws + WS_A2); bf16_t* const ZB = (bf16_t*)(ws + WS_Z); bf16_t* const ACT = ZB;
    float* const SS = (float*)(ws + WS_SS); float* const R = a.out;
    LAS float* const EP = (LAS float*)(lds + EPI_OFF);

    if (IN(0)) { p0_prologue(a, lds, gw, NGW, lane, wave); }
    SEAM(0);
    if (IN(1)) {
        pg8::Gemm g{HB, (const bf16_t*)(ws + WS_WGU1), M, NGU, D, D, D}; pg8::StaticOrder S; S.init(M, NGU, G, bx);
        pg8::EpiSwiGLU E{ACT, SS}; pg8::gemm_phase<pg8::EpiSwiGLU, true>(lds, g, S, E);
    }
    SEAM(1);
    if (IN(2)) {
        pg8::Gemm g{ACT, (const bf16_t*)(ws + WS_WDN1), M, D, DFF, DFF, DFF}; pg8::StaticOrder S; S.init(M, D, G, bx);
        pg8::EpiResid E{a.x, R, HB, SS, 0.5f, EP}; pg8::gemm_phase<pg8::EpiResid, true>(lds, g, S, E);
    }
    SEAM(2);
#if EN_MIX
    if (IN(3)) {
        pg8::Gemm g{HB, (const bf16_t*)(ws + WS_WIN), M, NIN, D, D, D}; pg8::StaticOrder S; S.init(M, NIN, G, bx);
        pg8::EpiWin E{ZB, (float*)(ws + WS_ZIF), a.bin, SS}; pg8::gemm_phase<pg8::EpiWin, true>(lds, g, S, E);
    }
    SEAM(3);
    if (IN(4)) { for (int i = 0; i < NUNIT / 256; ++i) p4_unit(a, lds, vcu * (NUNIT / 256) + i); }
    SEAM(4);
    if (IN(5) && EN_MLSTM) { p5_scan(a, vcu); }
    SEAM(5);
    if (IN(6) && EN_MLSTM) { for (int i = 0; i < NUNIT / 256; ++i) p6_unit(a, lds, vcu * (NUNIT / 256) + i); }
    SEAM(6);
    if (IN(7)) {
#if EN_MLSTM
        { pg8::Gemm g{A2, (const bf16_t*)(ws + WS_WAB), M, D, 512, D, D}; pg8::StaticOrder S; S.init(M, D, G, bx);
          pg8::EpiMerge<false> E{HB, ZB, ZC_GA}; pg8::gemm_phase<pg8::EpiMerge<false>, true>(lds, g, S, E); }
        { pg8::Gemm g{A2 + 512, (const bf16_t*)(ws + WS_WAB) + 512, M, D, 512, D, D}; pg8::StaticOrder S; S.init(M, D, G, bx);
          pg8::EpiMerge<true> E{HB, ZB, ZC_GB}; pg8::gemm_phase<pg8::EpiMerge<true>, true>(lds, g, S, E); }
#else
        { pg8::Gemm g{A2 + 512, (const bf16_t*)(ws + WS_WAB) + 512, M, D, 512, D, D}; pg8::StaticOrder S; S.init(M, D, G, bx);
          pg8::EpiMerge<false> E{HB, ZB, ZC_GB}; pg8::gemm_phase<pg8::EpiMerge<false>, true>(lds, g, S, E); }
#endif
    }
    SEAM(7);
    if (IN(8)) {
        pg8::Gemm g{HB, (const bf16_t*)(ws + WS_WOUT), M, D, D, D, D}; pg8::StaticOrder S; S.init(M, D, G, bx);
        pg8::EpiResid E{R, R, A2, SS, 1.0f, EP}; pg8::gemm_phase<pg8::EpiResid, true>(lds, g, S, E);
    }
    SEAM(8);
#else
    SEAM(3); SEAM(4); SEAM(5); SEAM(6); SEAM(7); SEAM(8);
#endif
#if EN_FFN2
    if (IN(9)) {
        pg8::Gemm g{EN_MIX ? A2 : HB, (const bf16_t*)(ws + WS_WGU2), M, NGU, D, D, D}; pg8::StaticOrder S; S.init(M, NGU, G, bx);
        pg8::EpiSwiGLU E{ACT, SS}; pg8::gemm_phase<pg8::EpiSwiGLU, true>(lds, g, S, E);
    }
    SEAM(9);
    if (IN(10)) {
        pg8::Gemm g{ACT, (const bf16_t*)(ws + WS_WDN2), M, D, DFF, DFF, DFF}; pg8::StaticOrder S; S.init(M, D, G, bx);
        pg8::EpiResid E{R, R, nullptr, SS, 0.5f, EP}; pg8::gemm_phase<pg8::EpiResid, true>(lds, g, S, E);
    }
    SEAM(10);
#else
    SEAM(9); SEAM(10);
#endif
    if (IN(11)) { p_final(a, gw, NGW, lane); }
#undef IN
#undef SEAM
}

extern "C" void kernel_launch(void* const* d_in, const int* in_sizes, int n_in, void* d_out, int out_size, void* d_ws, size_t ws_size, hipStream_t stream) {
    static int grid = 0;
    if (grid == 0) {
        if (n_in != 18 || in_sizes[0] != M * D || out_size != M * D || ws_size < WS_END) { fprintf(stderr, "kernel_launch: unexpected problem (n_in %d, in0 %d, out %d, ws %zu)\n", n_in, n_in > 0 ? in_sizes[0] : -1, out_size, ws_size); grid = -1; return; }
        int dev = 0, cus = 0, per_cu = 0;
        if (hipGetDevice(&dev) != hipSuccess || hipDeviceGetAttribute(&cus, hipDeviceAttributeMultiprocessorCount, dev) != hipSuccess) { grid = -1; return; }
        if (hipFuncSetAttribute((const void*)fwd_kernel, hipFuncAttributeMaxDynamicSharedMemorySize, LDS_BYTES) != hipSuccess) { fprintf(stderr, "kernel_launch: hipFuncSetAttribute failed\n"); grid = -1; return; }
        if (hipOccupancyMaxActiveBlocksPerMultiprocessor(&per_cu, (const void*)fwd_kernel, 512, LDS_BYTES) != hipSuccess || per_cu < 1) { fprintf(stderr, "kernel_launch: occupancy query reports %d\n", per_cu); }
        (void)hipGetLastError();
        grid = cus;
        if (grid != 256) { fprintf(stderr, "kernel_launch: %d CUs; this kernel is laid out for 256\n", grid); grid = -1; return; }
    }
    if (grid < 0) return;
    if (hipMemsetAsync((char*)d_ws + WS_CTL, 0, CTL_ZERO_BYTES, stream) != hipSuccess) return;
    Args a{};
    a.x = (const float*)d_in[0]; a.n1g = (const float*)d_in[1]; a.wgu1 = (const float*)d_in[2]; a.wdn1 = (const float*)d_in[3]; a.mng = (const float*)d_in[4];
    a.win = (const float*)d_in[5]; a.bin = (const float*)d_in[6]; a.convw = (const float*)d_in[7]; a.hng = (const float*)d_in[8]; a.pa = (const float*)d_in[9];
    a.wpool = (const float*)d_in[10]; a.pscale = (const float*)d_in[11]; a.pb = (const float*)d_in[12]; a.wout = (const float*)d_in[13]; a.n2g = (const float*)d_in[14];
    a.wgu2 = (const float*)d_in[15]; a.wdn2 = (const float*)d_in[16]; a.fng = (const float*)d_in[17];
    a.out = (float*)d_out; a.ws = (unsigned char*)d_ws;
    if (MK_N_LAUNCHES == 1) { a.ph_lo = 0; a.ph_hi = NPHASE; hipLaunchKernelGGL(fwd_kernel, dim3(grid), dim3(512), LDS_BYTES, stream, a); }
    else for (int p = 0; p < NPHASE; ++p) { a.ph_lo = p; a.ph_hi = p + 1; hipLaunchKernelGGL(fwd_kernel, dim3(grid), dim3(512), LDS_BYTES, stream, a); }
}
```

```cpp
#include <hip/hip_runtime.h>
#include <cstdio>

#ifndef MK_N_LAUNCHES
#define MK_N_LAUNCHES 1
#endif
#ifndef EN_MIX
#define EN_MIX 1
#endif
#ifndef EN_FFN2
#define EN_FFN2 1
#endif
#ifndef EN_MLSTM
#define EN_MLSTM 1
#endif
#ifndef P5_CONSTBM
#define P5_CONSTBM 0
#endif
#ifndef P5_NODN
#define P5_NODN 0
#endif
#ifndef P6_SANITIZE
#define P6_SANITIZE 0
#endif
#ifndef P4_SYNTH
#define P4_SYNTH 0
#endif
#ifndef PROBE_REP_MLSTM
#define PROBE_REP_MLSTM 1
#endif
#ifndef PROBE_REP_P1
#define PROBE_REP_P1 1
#endif
#ifndef PROBE_REP_P2
#define PROBE_REP_P2 1
#endif
#ifndef PROBE_DUP5
#define PROBE_DUP5 0
#endif
#ifndef PROBE_DUP4
#define PROBE_DUP4 0
#endif
#ifndef PROBE_TIME
#define PROBE_TIME 0
#endif
#ifndef PROBE_PHASE
#define PROBE_PHASE 11
#endif
#ifndef P5_ZERO
#define P5_ZERO 0
#endif
#ifndef P6_NOSTATE
#define P6_NOSTATE 0
#endif

#define LAS __attribute__((address_space(3)))
#define GAS __attribute__((address_space(1)))
typedef unsigned short bf16_t;
typedef short bf16x8 __attribute__((ext_vector_type(8)));
typedef float f32x4 __attribute__((ext_vector_type(4)));
typedef float f32x2 __attribute__((ext_vector_type(2)));
typedef unsigned u32x4 __attribute__((ext_vector_type(4)));
typedef unsigned u32x2 __attribute__((ext_vector_type(2)));
typedef GAS unsigned gu32;

constexpr int BATCH = 8, SEQ = 8192, D = 1024, M = BATCH * SEQ, DFF = 2816, NGU = 2 * DFF;
constexpr int NH = 4, DH = 128, CH = 64, NCH = SEQ / CH, NUNIT = BATCH * NCH * NH;
constexpr int DIN = 4616, NIN = 4864, ZW = 4608;
constexpr int ZC_Q = 0, ZC_K = 512, ZC_V = 1024, ZC_O = 1536, ZC_U = 2048, ZC_GA = 2560, ZC_GB = 3584;
constexpr float EPS = 1e-6f;
constexpr int NPHASE = 12;

constexpr size_t MiB = 1u << 20;
constexpr size_t WS_CTL = 0, CTL_ZERO_BYTES = 1 * MiB;
constexpr size_t WS_WGU1 = 1 * MiB;
constexpr size_t WS_WDN1 = WS_WGU1 + (size_t)NGU * D * 2;
constexpr size_t WS_WIN = WS_WDN1 + (size_t)D * DFF * 2;
constexpr size_t WS_WAB = WS_WIN + (size_t)NIN * D * 2;
constexpr size_t WS_WOUT = WS_WAB + (size_t)D * D * 2;
constexpr size_t WS_WGU2 = WS_WOUT + (size_t)D * D * 2;
constexpr size_t WS_WDN2 = WS_WGU2 + (size_t)NGU * D * 2;
constexpr size_t WS_WEND = WS_WDN2 + (size_t)D * DFF * 2;
constexpr size_t WS_SS = 48 * MiB;
constexpr size_t WS_ZIF = 49 * MiB;
constexpr size_t WS_NST = 51 * MiB;
constexpr size_t WS_UB = 53 * MiB, WS_UM = WS_UB + 65536, WS_UMS = WS_UM + 65536;
constexpr size_t WS_NST2 = 54 * MiB;
constexpr size_t WS_H = 64 * MiB;
constexpr size_t WS_A2 = 192 * MiB;
constexpr size_t WS_CST = 320 * MiB;
constexpr size_t WS_Z = 448 * MiB;
constexpr size_t WS_END = 1024 * MiB;
static_assert(WS_WEND <= WS_SS && WS_Z + (size_t)M * ZW * 2 <= WS_END && WS_CST + (size_t)NUNIT * DH * DH * 2 <= WS_Z, "ws map");
constexpr int CW_TMO = 0, CW_BAR = 4096;

constexpr int RING_BYTES = 131072, EPI_OFF = RING_BYTES, EPI_BYTES = 4096, LDS_BYTES = 147456, MISC_OFF = LDS_BYTES - 256;

#define RLX_AGENT __ATOMIC_RELAXED, __HIP_MEMORY_SCOPE_AGENT
typedef __bf16 bf16x2_t __attribute__((ext_vector_type(2)));
__device__ __forceinline__ unsigned cvt_pk_bf16(float lo, float hi) { const f32x2 v = {lo, hi}; return __builtin_bit_cast(unsigned, __builtin_convertvector(v, bf16x2_t)); }
__device__ __forceinline__ float bf_lo(unsigned w) { return __uint_as_float(w << 16); }
__device__ __forceinline__ float bf_hi(unsigned w) { return __uint_as_float(w & 0xffff0000u); }
__device__ __forceinline__ float fast_exp(float x) { return __builtin_amdgcn_exp2f(x * 1.44269504089f); }
__device__ __forceinline__ float fast_sigmoid(float x) { return __builtin_amdgcn_rcpf(1.0f + fast_exp(-x)); }

#define XB_TMO      128
#define XB_XCNT(j)  (256  + 64 * (j))
#define XB_XSUB(j)  (1280 + 64 * (j))
#define XB_XGEN(j)  (2304 + 64 * (j))
#define XB_TOP      3328
#define XB_TOPGEN   3392
#define XCD_BAR_WORDS 3456
#define XB_SPIN_CAP (1u << 18)
__device__ __forceinline__ unsigned xb_ld(unsigned* p)              { return __hip_atomic_load(p, __ATOMIC_RELAXED, __HIP_MEMORY_SCOPE_AGENT); }
__device__ __forceinline__ unsigned xb_add(unsigned* p, unsigned v) { return __hip_atomic_fetch_add(p, v, __ATOMIC_RELAXED, __HIP_MEMORY_SCOPE_AGENT); }
__device__ __forceinline__ unsigned xb_xcc_id() { return (unsigned)__builtin_amdgcn_s_getreg((3 << 11) | 20) & 0xFu; }
#define XB_SPIN(cond, bar) do { unsigned _sp = 0; while (cond) { __builtin_amdgcn_s_sleep(1); \
    if ((++_sp & 255u) == 0u) { if (xb_ld(&(bar)[XB_TMO])) break; if (_sp > XB_SPIN_CAP) { atomicAdd(&(bar)[XB_TMO], 1u); break; } } } } while (0)
struct XcdBarrier { unsigned* bar; unsigned x; volatile LAS unsigned* st; };
__device__ __forceinline__ XcdBarrier xcd_barrier_post(unsigned* bar, volatile LAS unsigned* st) {
    XcdBarrier b; b.bar = bar; b.x = xb_xcc_id(); b.st = st;
    if (threadIdx.x == 0) (void)xb_add(&bar[XB_XCNT(b.x)], 1u);
    return b;
}
__device__ __forceinline__ void xcd_barrier_complete(unsigned* bar, unsigned x, unsigned& nloc, unsigned& nx) {
    const unsigned G = gridDim.x * gridDim.y * gridDim.z;
    unsigned sum, cnt, mine, sp = 0u;
    for (;;) {
        sum = 0u; cnt = 0u; mine = 0u;
#pragma unroll
        for (unsigned j = 0; j < 16; ++j) { const unsigned c = xb_ld(&bar[XB_XCNT(j)]); sum += c; cnt += (c > 0u) ? 1u : 0u; mine = (j == x) ? c : mine; }
        if (sum == G) break;
        __builtin_amdgcn_s_sleep(1);
        if ((++sp & 255u) == 0u) { if (xb_ld(&bar[XB_TMO])) break; if (sp > XB_SPIN_CAP) { atomicAdd(&bar[XB_TMO], 1u); break; } }
    }
    nloc = mine > 0u ? mine : 1u; nx = cnt > 0u ? cnt : 1u;
}
__device__ __forceinline__ void xcd_barrier(const XcdBarrier& b) {
    asm volatile("s_waitcnt vmcnt(0)" ::: "memory");
    __syncthreads();
    if (threadIdx.x == 0) {
        unsigned* bar = b.bar;
        __builtin_amdgcn_s_waitcnt(0);
        unsigned nloc = b.st[0], nx = b.st[1];
        if (nloc == 0u) { xcd_barrier_complete(bar, b.x, nloc, nx); b.st[0] = nloc; b.st[1] = nx; }
        const unsigned old = xb_add(&bar[XB_XSUB(b.x)], 1u);
        const unsigned gen = old / nloc;
        if (old + 1u == (gen + 1u) * nloc) {
            __builtin_amdgcn_fence(__ATOMIC_RELEASE, "agent");
            asm volatile("s_waitcnt vmcnt(0)" ::: "memory");
            const unsigned og = xb_add(&bar[XB_TOP], 1u);
            const unsigned tg = og / nx;
            if (og + 1u == (tg + 1u) * nx) xb_add(&bar[XB_TOPGEN], 1u);
            else XB_SPIN(xb_ld(&bar[XB_TOPGEN]) == tg, bar);
            __builtin_amdgcn_fence(__ATOMIC_ACQUIRE, "agent");
            xb_add(&bar[XB_XGEN(b.x)], 1u);
            asm volatile("s_waitcnt vmcnt(0)" ::: "memory");
        } else {
            XB_SPIN(xb_ld(&bar[XB_XGEN(b.x)]) == gen, bar);
            __builtin_amdgcn_fence(__ATOMIC_ACQUIRE, "agent");
            asm volatile("s_waitcnt vmcnt(0)" ::: "memory");
        }
    }
    __syncthreads();
}

namespace pg8 {
constexpr int BM = 256, BK = 64, HALF = 128, HTB = HALF * BK * 2, STAGE_BYTES = 8 * HTB, NXCD = 8, WGM = 8;
__host__ __device__ __forceinline__ int lds_byte(int r, int c) { const int st = (r >> 4) * 2 + (c >> 5), rr = r & 15, cc = c & 31, ob = rr * 64 + cc * 2; return st * 1024 + (ob ^ (((ob >> 9) & 1) << 5)); }
__host__ __device__ __forceinline__ void stage_rc(int b, int& R, int& C) { const int st = b / 1024, sb = b % 1024, swz = sb ^ (((sb >> 9) & 1) << 5); R = (st >> 1) * 16 + swz / 64; C = (st & 1) * 32 + (swz % 64) / 2; }
__host__ __device__ __forceinline__ int perm32(int rho) { const int n = rho >> 4, i = rho & 15; return 8 * (i >> 2) + 4 * n + (i & 3); }
struct Unit { int pm, pn; };
struct Gemm { const bf16_t* A; const bf16_t* Bt; int M, N, K, lda, ldb; };
struct StaticOrder {
    int nM, nN, nwg, G, c;
    __host__ __device__ void init(int M_, int N_, int G_, int c_) { nM = M_ / BM; nN = N_ / BM; nwg = nM * nN; G = G_; c = c_; }
    __host__ __device__ bool next(int i, Unit& u) const {
        const long L = (long)i * G + c; if (L >= nwg) return false;
        int wgid = (int)L; { const int q = nwg / NXCD, r = nwg % NXCD, xcd = wgid % NXCD, off = wgid / NXCD; wgid = (xcd < r ? xcd * (q + 1) : r * (q + 1) + (xcd - r) * q) + off; }
        const int nig = WGM * nN, gid = wgid / nig, fm = gid * WGM, gsz = (nM - fm) < WGM ? (nM - fm) : WGM;
        u.pm = fm + ((wgid % nig) % gsz); u.pn = (wgid % nig) / gsz; return true;
    }
};
template <class Epi, bool ALIGN_EPI>
__device__ __forceinline__ void gemm_phase(LAS unsigned char* lds, const Gemm g, const StaticOrder& S, const Epi& E, unsigned long long* tacc = nullptr) {
    const int tid = threadIdx.x, wid = __builtin_amdgcn_readfirstlane(tid >> 6), lane = tid & 63, wr = wid >> 2, wc = wid & 3, fr = lane & 15, fq = lane >> 4;
    const int K = g.K, nt = K / BK;
    unsigned voffA[2], voffB[2];
#pragma unroll
    for (int i = 0; i < 2; ++i) { int R, C; stage_rc(tid * 16 + i * 8192, R, C); const int Rb = (R & ~31) + perm32(R & 31);
        voffA[i] = (unsigned)(R * g.lda + C) * 2u; voffB[i] = (unsigned)(Rb * g.ldb + C) * 2u; }
    const size_t kstep = (size_t)(BK * 2);
    const size_t hstepA = (size_t)HALF * g.lda * 2, hstepB = (size_t)HALF * g.ldb * 2;
    const size_t tstepA = 2 * hstepA, tstepB = 2 * hstepB;
    const unsigned ldsw = (unsigned)wid * 1024u;
    const int aoff = lds_byte(wr * 64 + fr, fq * 8), boff = lds_byte(wc * 32 + fr, fq * 8);
#define PG8_SA(b, h) (((b) * 2 + (h)) * HTB)
#define PG8_SB(b, h) ((4 + (b) * 2 + (h)) * HTB)
#define PG8_STAGE(bufoff, gbase, voff) do { _Pragma("unroll") for (int _i = 0; _i < 2; ++_i) \
        __builtin_amdgcn_global_load_lds((const unsigned*)((const char*)(gbase) + (voff)[_i]), (LAS unsigned*)(lds + (bufoff) + ldsw + _i * 8192), 16, 0, 0); } while (0)
#define PG8_LDA(dst, b, h) do { _Pragma("unroll") for (int m = 0; m < 4; ++m) _Pragma("unroll") for (int k = 0; k < 2; ++k) dst[m][k] = *(const LAS bf16x8*)(lds + PG8_SA(b, h) + aoff + m * 2048 + k * 1024); } while (0)
#define PG8_LDB(dst, b, h) do { _Pragma("unroll") for (int n = 0; n < 2; ++n) _Pragma("unroll") for (int k = 0; k < 2; ++k) dst[n][k] = *(const LAS bf16x8*)(lds + PG8_SB(b, h) + boff + n * 2048 + k * 1024); } while (0)
#define PG8_MMA(ai, bj, At, Bt) do { __builtin_amdgcn_s_setprio(1); _Pragma("unroll") for (int m = 0; m < 4; ++m) _Pragma("unroll") for (int n = 0; n < 2; ++n) _Pragma("unroll") for (int k = 0; k < 2; ++k) \
        acc[ai][bj][m][n] = __builtin_amdgcn_mfma_f32_16x16x32_bf16(Bt[n][k], At[m][k], acc[ai][bj][m][n], 0, 0, 0); __builtin_amdgcn_s_setprio(0); } while (0)
#define PG8_WAIT_V(n) asm volatile("s_waitcnt vmcnt(" #n ")" ::: "memory")
#define PG8_WAIT_L(n) asm volatile("s_waitcnt lgkmcnt(" #n ")" ::: "memory")
#define PG8_BAR __builtin_amdgcn_s_barrier()
#define PG8_SCHED __builtin_amdgcn_sched_barrier(0)
    Unit cur, nxt; int ui = 0;
    if (!S.next(0, cur)) return;
    f32x4 acc[2][2][4][2];
#pragma unroll
    for (int a = 0; a < 2; ++a)
#pragma unroll
        for (int b = 0; b < 2; ++b)
#pragma unroll
            for (int m = 0; m < 4; ++m)
#pragma unroll
                for (int n = 0; n < 2; ++n) acc[a][b][m][n] = (f32x4){0.f, 0.f, 0.f, 0.f};
    bf16x8 At[4][2], B0[2][2], B1[2][2];
    const char* cA = (const char*)g.A + (size_t)cur.pm * tstepA; const char* cB = (const char*)g.Bt + (size_t)cur.pn * tstepB;
    PG8_STAGE(PG8_SB(0, 0), cB, voffB); PG8_STAGE(PG8_SB(0, 1), cB + hstepB, voffB); PG8_STAGE(PG8_SA(0, 0), cA, voffA); PG8_STAGE(PG8_SA(0, 1), cA + hstepA, voffA);
    if (wr == 1) PG8_BAR;
    PG8_WAIT_V(2); PG8_BAR;
    PG8_STAGE(PG8_SB(1, 0), cB + kstep, voffB); PG8_STAGE(PG8_SA(1, 0), cA + kstep, voffA); PG8_STAGE(PG8_SB(1, 1), cB + hstepB + kstep, voffB);
    PG8_WAIT_V(6); PG8_BAR;
    for (;;) {
        const bool has_next = S.next(ui + 1, nxt);
        const char* nA = has_next ? (const char*)g.A + (size_t)nxt.pm * tstepA : cA; const char* nB = has_next ? (const char*)g.Bt + (size_t)nxt.pn * tstepB : cB;
        for (int t = 0; t < nt; t += 2) {
            const bool last = (t == nt - 2);
            const char* a1 = cA + (size_t)(t + 1) * kstep;
            const char* a2 = last ? nA : cA + (size_t)(t + 2) * kstep; const char* b2 = last ? nB : cB + (size_t)(t + 2) * kstep;
            const char* a3 = a2 + kstep; const char* b3 = b2 + kstep;
            PG8_LDB(B0, 0, 0); PG8_LDB(B1, 0, 1); PG8_SCHED; PG8_LDA(At, 0, 0); PG8_STAGE(PG8_SA(1, 1), a1 + hstepA, voffA);
            PG8_WAIT_V(8); PG8_WAIT_L(0); PG8_BAR; PG8_MMA(0, 0, At, B0); PG8_MMA(0, 1, At, B1); PG8_BAR; PG8_SCHED;
            PG8_LDA(At, 0, 1); PG8_STAGE(PG8_SB(0, 0), b2, voffB); PG8_STAGE(PG8_SB(0, 1), b2 + hstepB, voffB); PG8_STAGE(PG8_SA(0, 0), a2, voffA);
            PG8_WAIT_V(8); PG8_WAIT_L(0); PG8_BAR; PG8_MMA(1, 0, At, B0); PG8_MMA(1, 1, At, B1); PG8_BAR; PG8_SCHED;
            PG8_LDB(B0, 1, 0); PG8_LDB(B1, 1, 1); PG8_SCHED; PG8_LDA(At, 1, 0); PG8_STAGE(PG8_SA(0, 1), a2 + hstepA, voffA);
            PG8_WAIT_V(8); PG8_WAIT_L(0); PG8_BAR; PG8_MMA(0, 0, At, B0); PG8_MMA(0, 1, At, B1); PG8_BAR; PG8_SCHED;
            PG8_LDA(At, 1, 1); PG8_STAGE(PG8_SB(1, 0), b3, voffB); PG8_STAGE(PG8_SB(1, 1), b3 + hstepB, voffB); PG8_STAGE(PG8_SA(1, 0), a3, voffA);
            PG8_WAIT_V(8); PG8_WAIT_L(0); PG8_BAR; PG8_MMA(1, 0, At, B0); PG8_MMA(1, 1, At, B1); PG8_BAR; PG8_SCHED;
        }
        if constexpr (ALIGN_EPI) { if (wr == 0) PG8_BAR; }
#if PROBE_TIME
        const unsigned long long tp0 = __builtin_amdgcn_s_memrealtime();
#endif
        E(acc, cur, wid, wr, wc, fr, fq);
#if PROBE_TIME
        if (tacc) *tacc += __builtin_amdgcn_s_memrealtime() - tp0;
#endif
        if (!has_next) break;
#pragma unroll
        for (int a = 0; a < 2; ++a)
#pragma unroll
            for (int b = 0; b < 2; ++b)
#pragma unroll
                for (int m = 0; m < 4; ++m)
#pragma unroll
                    for (int n = 0; n < 2; ++n) acc[a][b][m][n] = (f32x4){0.f, 0.f, 0.f, 0.f};
        cur = nxt; cA = nA; cB = nB; ++ui;
        if constexpr (ALIGN_EPI) { if (wr == 1) PG8_BAR; }
    }
    PG8_WAIT_V(0);
    if constexpr (!ALIGN_EPI) { if (wr == 0) PG8_BAR; }
    PG8_BAR;
#undef PG8_SA
#undef PG8_SB
#undef PG8_STAGE
#undef PG8_LDA
#undef PG8_LDB
#undef PG8_MMA
#undef PG8_WAIT_V
#undef PG8_WAIT_L
#undef PG8_BAR
#undef PG8_SCHED
}

typedef const f32x4 (&AccRef)[2][2][4][2];
__device__ __forceinline__ void load_rs8(const float* ss, int row0, float (&r)[8]) {
    float p[8][4];
#pragma unroll
    for (int i = 0; i < 8; ++i)
#pragma unroll
        for (int q = 0; q < 4; ++q) p[i][q] = ss[(size_t)q * M + row0 + (i >> 2) * HALF + (i & 3) * 16];
    asm volatile("" ::: "memory");
#pragma unroll
    for (int i = 0; i < 8; ++i) r[i] = __builtin_amdgcn_rsqf(((p[i][0] + p[i][1]) + (p[i][2] + p[i][3])) * (1.0f / D) + EPS);
}
template <bool RS> struct EpiSwiGLU {
    bf16_t* act; const float* ss;
    __device__ __forceinline__ void operator()(AccRef acc, const Unit& u, int wid, int wr, int wc, int fr, int fq) const {
        const int row0 = u.pm * BM + wr * 64 + fr, col0 = u.pn * HALF + wc * 32 + 8 * fq;
        float rs[8];
        if constexpr (RS) load_rs8(ss, row0, rs); else {
#pragma unroll
            for (int i = 0; i < 8; ++i) rs[i] = 1.0f; }
#pragma unroll
        for (int ai = 0; ai < 2; ++ai)
#pragma unroll
            for (int m = 0; m < 4; ++m) {
                const int row = row0 + ai * HALF + m * 16; const float r = rs[ai * 4 + m]; float o[8];
#pragma unroll
                for (int n = 0; n < 2; ++n)
#pragma unroll
                    for (int j = 0; j < 4; ++j) { const float gt = acc[ai][0][m][n][j] * r, up = acc[ai][1][m][n][j] * r; o[n * 4 + j] = gt * fast_sigmoid(gt) * up; }
                u32x4 w; w.x = cvt_pk_bf16(o[0], o[1]); w.y = cvt_pk_bf16(o[2], o[3]); w.z = cvt_pk_bf16(o[4], o[5]); w.w = cvt_pk_bf16(o[6], o[7]);
                *(u32x4*)(act + (size_t)row * DFF + col0) = w;
            }
    }
};
template <bool BASE_BF16, bool OUT_BF16> struct EpiResid {
    const void* base; void* out; float* ss; float alpha; LAS float* P;
    __device__ __forceinline__ void operator()(AccRef acc, const Unit& u, int wid, int wr, int wc, int fr, int fq) const {
        const int rl0 = wr * 64 + fr, col0 = u.pn * BM + wc * 32 + 8 * fq;
        u32x4 bb[2][4][2];
        if constexpr (BASE_BF16) {
#pragma unroll
            for (int ai = 0; ai < 2; ++ai)
#pragma unroll
                for (int m = 0; m < 4; ++m)
#pragma unroll
                    for (int bj = 0; bj < 2; ++bj) bb[ai][m][bj] = *(const u32x4*)((const bf16_t*)base + (size_t)(u.pm * BM + rl0 + ai * HALF + m * 16) * D + col0 + bj * HALF);
            asm volatile("" ::: "memory");
        }
#pragma unroll
        for (int ai = 0; ai < 2; ++ai) {
            f32x4 b[4][2][2];
            if constexpr (!BASE_BF16) {
#pragma unroll
                for (int m = 0; m < 4; ++m)
#pragma unroll
                    for (int bj = 0; bj < 2; ++bj) { const size_t off = (size_t)(u.pm * BM + rl0 + ai * HALF + m * 16) * D + col0 + bj * HALF;
                        b[m][bj][0] = *(const f32x4*)((const float*)base + off); b[m][bj][1] = *(const f32x4*)((const float*)base + off + 4); }
                asm volatile("" ::: "memory");
            } else {
#pragma unroll
                for (int m = 0; m < 4; ++m)
#pragma unroll
                    for (int bj = 0; bj < 2; ++bj) { const u32x4 q = bb[ai][m][bj];
                        b[m][bj][0] = (f32x4){bf_lo(q.x), bf_hi(q.x), bf_lo(q.y), bf_hi(q.y)}; b[m][bj][1] = (f32x4){bf_lo(q.z), bf_hi(q.z), bf_lo(q.w), bf_hi(q.w)}; }
            }
#pragma unroll
            for (int m = 0; m < 4; ++m) {
                const int rl = rl0 + ai * HALF + m * 16; const size_t off = (size_t)(u.pm * BM + rl) * D + col0; float s = 0.f;
#pragma unroll
                for (int bj = 0; bj < 2; ++bj) {
                    const f32x4 v0 = b[m][bj][0] + acc[ai][bj][m][0] * alpha, v1 = b[m][bj][1] + acc[ai][bj][m][1] * alpha;
                    if constexpr (OUT_BF16) { u32x4 w; w.x = cvt_pk_bf16(v0[0], v0[1]); w.y = cvt_pk_bf16(v0[2], v0[3]); w.z = cvt_pk_bf16(v1[0], v1[1]); w.w = cvt_pk_bf16(v1[2], v1[3]); *(u32x4*)((bf16_t*)out + off + bj * HALF) = w; }
                    else { *(f32x4*)((float*)out + off + bj * HALF) = v0; *(f32x4*)((float*)out + off + bj * HALF + 4) = v1; }
                    s += (v0[0] * v0[0] + v0[1] * v0[1]) + (v0[2] * v0[2] + v0[3] * v0[3]) + (v1[0] * v1[0] + v1[1] * v1[1]) + (v1[2] * v1[2] + v1[3] * v1[3]);
                }
                if (ss) { s += __shfl_xor(s, 16); s += __shfl_xor(s, 32); if (fq == 0) P[rl * 4 + wc] = s; }
            }
        }
        if (ss) {
            asm volatile("s_waitcnt lgkmcnt(0)" ::: "memory"); __builtin_amdgcn_s_barrier(); asm volatile("" ::: "memory");
            const int t = threadIdx.x;
            if (t < 256) { const f32x4 p = *(const LAS f32x4*)(P + t * 4); ss[(size_t)u.pn * M + u.pm * BM + t] = (p[0] + p[1]) + (p[2] + p[3]); }
        }
    }
};
struct EpiWin {
    bf16_t* z; float* zif; const float* bias; const float* ss;
    __device__ __forceinline__ void operator()(AccRef acc, const Unit& u, int wid, int wr, int wc, int fr, int fq) const {
        const int row0 = u.pm * BM + wr * 64 + fr, col0 = u.pn * BM + wc * 32 + 8 * fq;
        float rs[8]; load_rs8(ss, row0, rs);
        if (u.pn == 18) {
            if (wc == 0 && fq == 0) {
                const f32x4 bi = *(const f32x4*)(bias + ZW), bf = *(const f32x4*)(bias + ZW + 4);
#pragma unroll
                for (int ai = 0; ai < 2; ++ai)
#pragma unroll
                    for (int m = 0; m < 4; ++m) {
                        const int row = row0 + ai * HALF + m * 16; const float r = rs[ai * 4 + m];
                        const f32x4 vi = acc[ai][0][m][0] * r + bi, vf = acc[ai][0][m][1] * r + bf; f32x4 lf;
#pragma unroll
                        for (int j = 0; j < 4; ++j) { const float x = vf[j]; lf[j] = fminf(x, 0.f) - __logf(1.0f + __expf(-fabsf(x))); }
                        *(f32x4*)(zif + (size_t)row * 8) = vi; *(f32x4*)(zif + (size_t)row * 8 + 4) = lf;
                    }
            }
            return;
        }
        const bool sg = (u.pn == 6) | (u.pn == 7) | (u.pn >= 10);
        f32x4 bv[2][2];
#pragma unroll
        for (int bj = 0; bj < 2; ++bj)
#pragma unroll
            for (int n = 0; n < 2; ++n) bv[bj][n] = *(const f32x4*)(bias + col0 + bj * HALF + 4 * n);
        asm volatile("" ::: "memory");
#pragma unroll
        for (int ai = 0; ai < 2; ++ai)
#pragma unroll
            for (int m = 0; m < 4; ++m) {
                const int row = row0 + ai * HALF + m * 16; const float r = rs[ai * 4 + m];
#pragma unroll
                for (int bj = 0; bj < 2; ++bj) {
                    f32x4 v0 = acc[ai][bj][m][0] * r + bv[bj][0], v1 = acc[ai][bj][m][1] * r + bv[bj][1];
                    if (sg) {
#pragma unroll
                        for (int j = 0; j < 4; ++j) { v0[j] = fast_sigmoid(v0[j]); v1[j] = fast_sigmoid(v1[j]); } }
                    u32x4 w; w.x = cvt_pk_bf16(v0[0], v0[1]); w.y = cvt_pk_bf16(v0[2], v0[3]); w.z = cvt_pk_bf16(v1[0], v1[1]); w.w = cvt_pk_bf16(v1[2], v1[3]);
                    *(u32x4*)(z + (size_t)row * ZW + col0 + bj * HALF) = w;
                }
            }
    }
};
template <bool ADD> struct EpiMerge {
    bf16_t* mg; const bf16_t* z; int gcol0;
    __device__ __forceinline__ void operator()(AccRef acc, const Unit& u, int wid, int wr, int wc, int fr, int fq) const {
        const int row0 = u.pm * BM + wr * 64 + fr, col0 = u.pn * BM + wc * 32 + 8 * fq;
#pragma unroll
        for (int ai = 0; ai < 2; ++ai) {
            u32x4 gt[4][2], pv[4][2];
#pragma unroll
            for (int m = 0; m < 4; ++m)
#pragma unroll
                for (int bj = 0; bj < 2; ++bj) { const int row = row0 + ai * HALF + m * 16;
                    gt[m][bj] = *(const u32x4*)(z + (size_t)row * ZW + gcol0 + col0 + bj * HALF);
                    if (ADD) pv[m][bj] = *(const u32x4*)(mg + (size_t)row * D + col0 + bj * HALF); }
            asm volatile("" ::: "memory");
#pragma unroll
            for (int m = 0; m < 4; ++m)
#pragma unroll
                for (int bj = 0; bj < 2; ++bj) { const int row = row0 + ai * HALF + m * 16; const u32x4 g = gt[m][bj];
                    f32x4 v0 = acc[ai][bj][m][0], v1 = acc[ai][bj][m][1];
                    v0[0] *= bf_lo(g.x); v0[1] *= bf_hi(g.x); v0[2] *= bf_lo(g.y); v0[3] *= bf_hi(g.y);
                    v1[0] *= bf_lo(g.z); v1[1] *= bf_hi(g.z); v1[2] *= bf_lo(g.w); v1[3] *= bf_hi(g.w);
                    if (ADD) { const u32x4 q = pv[m][bj];
                        v0[0] += bf_lo(q.x); v0[1] += bf_hi(q.x); v0[2] += bf_lo(q.y); v0[3] += bf_hi(q.y);
                        v1[0] += bf_lo(q.z); v1[1] += bf_hi(q.z); v1[2] += bf_lo(q.w); v1[3] += bf_hi(q.w); }
                    u32x4 w; w.x = cvt_pk_bf16(v0[0], v0[1]); w.y = cvt_pk_bf16(v0[2], v0[3]); w.z = cvt_pk_bf16(v1[0], v1[1]); w.w = cvt_pk_bf16(v1[2], v1[3]);
                    *(u32x4*)(mg + (size_t)row * D + col0 + bj * HALF) = w; }
        }
    }
};
}

struct Args {
    const float* x; const float* n1g; const float* wgu1; const float* wdn1; const float* mng; const float* win; const float* bin; const float* convw;
    const float* hng; const float* pa; const float* wpool; const float* pscale; const float* pb; const float* wout; const float* n2g; const float* wgu2; const float* wdn2; const float* fng;
    float* out; unsigned char* ws; int ph_lo, ph_hi;
};

__device__ __forceinline__ float wave_sum(float v) {
#pragma unroll
    for (int o = 1; o < 64; o <<= 1) v += __shfl_xor(v, o);
    return v;
}
__device__ __forceinline__ float wave_max(float v) {
#pragma unroll
    for (int o = 1; o < 64; o <<= 1) v = fmaxf(v, __shfl_xor(v, o));
    return v;
}
__device__ __forceinline__ void transpose_item(const float* W, int N, int nvalid, const float* gain, bf16_t* WT, int ldt, int k0, int n0, int drow0, LAS float* scr, int lane) {
#pragma unroll 8
    for (int i = 0; i < 32; ++i) { const int kk = 2 * i + (lane >> 5), n = n0 + (lane & 31);
        float v = 0.f; if (n < nvalid) { v = W[(size_t)(k0 + kk) * N + n]; if (gain) v *= gain[k0 + kk]; }
        scr[kk * 33 + (lane & 31)] = v; }
    asm volatile("s_waitcnt lgkmcnt(0)" ::: "memory");
    const int c = lane & 7;
#pragma unroll
    for (int j = 0; j < 4; ++j) { const int n = (lane >> 3) + 8 * j; const LAS float* s = scr + (8 * c) * 33 + n;
        u32x4 o; o.x = cvt_pk_bf16(s[0 * 33], s[1 * 33]); o.y = cvt_pk_bf16(s[2 * 33], s[3 * 33]); o.z = cvt_pk_bf16(s[4 * 33], s[5 * 33]); o.w = cvt_pk_bf16(s[6 * 33], s[7 * 33]);
        *(u32x4*)(WT + (size_t)(drow0 + n) * ldt + k0 + 8 * c) = o; }
    asm volatile("s_waitcnt lgkmcnt(0)" ::: "memory");
}
__device__ __forceinline__ int gu_row(int n0) {
    const int isup = n0 >= DFF, nn = isup ? n0 - DFF : n0; return 256 * (nn >> 7) + (isup ? 128 : 0) + (nn & 127);
}

__device__ __forceinline__ void p0_prologue(const Args& a, LAS unsigned char* lds, int gw, int NGW, int lane, int wave) {
    unsigned char* ws = a.ws;
    LAS float* scr = (LAS float*)(lds + wave * 16384);
    constexpr int I_GU = (D / 64) * (NGU / 32), I_DN = (DFF / 64) * (D / 32), I_IN = (D / 64) * (NIN / 32), I_PA = (512 / 64) * (D / 32), I_WO = (D / 64) * (D / 32);
    constexpr int NITEMS = 2 * I_GU + 2 * I_DN + I_IN + I_PA + I_WO;
    for (int it = gw; it < NITEMS; it += NGW) {
        int r = it;
        if (r < I_GU) { const int nb = r % (NGU / 32), kb = r / (NGU / 32); transpose_item(a.wgu1, NGU, NGU, a.n1g, (bf16_t*)(ws + WS_WGU1), D, kb * 64, nb * 32, gu_row(nb * 32) - 0, scr, lane); continue; } r -= I_GU;
        if (r < I_GU) { const int nb = r % (NGU / 32), kb = r / (NGU / 32); transpose_item(a.wgu2, NGU, NGU, a.n2g, (bf16_t*)(ws + WS_WGU2), D, kb * 64, nb * 32, gu_row(nb * 32) - 0, scr, lane); continue; } r -= I_GU;
        if (r < I_DN) { const int nb = r % (D / 32), kb = r / (D / 32); transpose_item(a.wdn1, D, D, nullptr, (bf16_t*)(ws + WS_WDN1), DFF, kb * 64, nb * 32, nb * 32, scr, lane); continue; } r -= I_DN;
        if (r < I_DN) { const int nb = r % (D / 32), kb = r / (D / 32); transpose_item(a.wdn2, D, D, nullptr, (bf16_t*)(ws + WS_WDN2), DFF, kb * 64, nb * 32, nb * 32, scr, lane); continue; } r -= I_DN;
        if (r < I_IN) { const int nb = r % (NIN / 32), kb = r / (NIN / 32); transpose_item(a.win, DIN, DIN, a.mng, (bf16_t*)(ws + WS_WIN), D, kb * 64, nb * 32, nb * 32, scr, lane); continue; } r -= I_IN;
        if (r < I_PA) { const int nb = r % (D / 32), kb = r / (D / 32); transpose_item(a.pa, D, D, nullptr, (bf16_t*)(ws + WS_WAB), D, kb * 64, nb * 32, nb * 32, scr, lane); continue; } r -= I_PA;
        { const int nb = r % (D / 32), kb = r / (D / 32); transpose_item(a.wout, D, D, nullptr, (bf16_t*)(ws + WS_WOUT), D, kb * 64, nb * 32, nb * 32, scr, lane); }
    }
    {
        bf16_t* wab = (bf16_t*)(ws + WS_WAB);
        const int gt = gw * 64 + lane, NT = NGW * 64;
        for (int o = gt; o < 512 * D; o += NT) {
            const int n = o & (D - 1), kk = o >> 10, g = kk >> 7;
            const float* wp = a.wpool + (size_t)kk * 128; const float* ps = a.pscale + g * 128; const float* pb = a.pb + (size_t)(g * 128) * D + n;
            float s = 0.f;
#pragma unroll 8
            for (int d = 0; d < 128; ++d) s += wp[d] * ps[d] * pb[(size_t)d * D];
            wab[(size_t)n * D + 512 + kk] = (bf16_t)(cvt_pk_bf16(s, 0.f) & 0xffffu);
        }
    }
    {
        bf16_t* hb = (bf16_t*)(ws + WS_H); float* ss = (float*)(ws + WS_SS);
        for (int m = gw; m < M; m += NGW) {
            const f32x4* xr = (const f32x4*)(a.x + (size_t)m * D) + lane; f32x4 v[4]; float s = 0.f;
#pragma unroll
            for (int j = 0; j < 4; ++j) { v[j] = xr[64 * j]; s += (v[j][0] * v[j][0] + v[j][1] * v[j][1]) + (v[j][2] * v[j][2] + v[j][3] * v[j][3]); }
            s = wave_sum(s);
            const float r = __builtin_amdgcn_rsqf(s * (1.0f / D) + EPS);
            u32x2* o8 = (u32x2*)(hb + (size_t)m * D) + lane;
#pragma unroll
            for (int j = 0; j < 4; ++j) { u32x2 w; w.x = cvt_pk_bf16(v[j][0] * r, v[j][1] * r); w.y = cvt_pk_bf16(v[j][2] * r, v[j][3] * r); o8[64 * j] = w; }
            if (lane < 4) ss[(size_t)lane * M + m] = lane == 0 ? s : 0.f;
        }
    }
}

constexpr int QP = 136, TP = 72;
__device__ __forceinline__ bf16x8 ldfrag(const LAS bf16_t* base, int pitch, int row, int kofs) { return *(const LAS bf16x8*)(base + row * pitch + kofs); }
__device__ __forceinline__ float silu_f(float x) { return x * fast_sigmoid(x); }
__device__ __forceinline__ void unpack8(const u32x4 v, float (&f)[8]) { f[0] = bf_lo(v.x); f[1] = bf_hi(v.x); f[2] = bf_lo(v.y); f[3] = bf_hi(v.y); f[4] = bf_lo(v.z); f[5] = bf_hi(v.z); f[6] = bf_lo(v.w); f[7] = bf_hi(v.w); }
__device__ __forceinline__ void load_taps(const bf16_t* z, int r0, int s, int seq0, int col, u32x4 (&t)[4]) {
#pragma unroll
    for (int j = 0; j < 4; ++j) { const int tt = s - 3 + j; t[j] = (u32x4){0u, 0u, 0u, 0u}; if (seq0 + tt >= 0) t[j] = *(const u32x4*)(z + (size_t)(r0 + tt) * ZW + col); }
}
__device__ __forceinline__ void conv_taps(const u32x4 (&t)[4], const LAS float* cw, int col, float (&o)[8]) {
#pragma unroll
    for (int e = 0; e < 8; ++e) o[e] = 0.f;
#pragma unroll
    for (int j = 0; j < 4; ++j) { float f[8]; unpack8(t[j], f);
        const f32x4 w0 = *(const LAS f32x4*)(cw + j * 1024 + col), w1 = *(const LAS f32x4*)(cw + j * 1024 + col + 4);
        o[0] += w0[0] * f[0]; o[1] += w0[1] * f[1]; o[2] += w0[2] * f[2]; o[3] += w0[3] * f[3];
        o[4] += w1[0] * f[4]; o[5] += w1[1] * f[5]; o[6] += w1[2] * f[6]; o[7] += w1[3] * f[7]; }
#pragma unroll
    for (int e = 0; e < 8; ++e) o[e] = silu_f(o[e]);
}
__device__ __forceinline__ bf16_t f2bf(float x) { return (bf16_t)(cvt_pk_bf16(x, 0.f) & 0xffffu); }

struct P4Regs { u32x4 kt[2][4]; u32x4 vv[2]; u32x4 uu[3]; float lf, ig; };
constexpr int P4_KT = 0, P4_VT = 18432, P4_US = 39168, P4_BUF = 60928, P4_CW = 2 * P4_BUF;
__device__ __forceinline__ void p4_prefetch(const Args& a, int u, P4Regs& R) {
    const bf16_t* z = (const bf16_t*)(a.ws + WS_Z); const float* zif = (const float*)(a.ws + WS_ZIF);
    const int tid = threadIdx.x, lane = tid & 63, wave = tid >> 6;
    const int h = u & 3, c = (u >> 2) & (NCH - 1), b = u >> 9, r0 = b * SEQ + c * CH, seq0 = c * CH;
    R.lf = zif[(size_t)(r0 + lane) * 8 + 4 + h]; R.ig = zif[(size_t)(r0 + lane) * 8 + h];
#pragma unroll
    for (int it = 0; it < 2; ++it) load_taps(z, r0, lane, seq0, ZC_K + h * DH + (wave + 8 * it) * 8, R.kt[it]);
#pragma unroll
    for (int it = 0; it < 2; ++it) R.vv[it] = *(const u32x4*)(z + (size_t)(r0 + lane) * ZW + ZC_V + h * DH + (wave + 8 * it) * 8);
#pragma unroll
    for (int it = 0; it < 3; ++it) { const int idx = tid + 512 * it, row = idx >> 4, cg = idx & 15; R.uu[it] = (u32x4){0u, 0u, 0u, 0u};
        if (idx < 79 * 16 && seq0 - 15 + row >= 0) R.uu[it] = *(const u32x4*)(z + (size_t)(r0 - 15 + row) * ZW + ZC_U + h * 128 + cg * 8); }
}
__device__ __forceinline__ void p4_phase(const Args& a, LAS unsigned char* lds, int vcu) {
    unsigned char* ws = a.ws;
    const int tid = threadIdx.x, lane = tid & 63, wave = tid >> 6, fr = lane & 15, fq = lane >> 4;
    LAS float* cw = (LAS float*)(lds + P4_CW);
    {
#pragma unroll
        for (int it = 0; it < 2; ++it) *(LAS f32x4*)(cw + (tid + 512 * it) * 4) = *(const f32x4*)(a.convw + (tid + 512 * it) * 4);
        for (int i = tid; i < 2 * 16 * TP / 2; i += 512) { const int bsel = i / (16 * TP / 2), w = i % (16 * TP / 2); ((LAS unsigned*)(lds + bsel * P4_BUF + P4_VT + 128 * TP * 2))[w] = 0u; }
    }
    __syncthreads();
    const int u0 = vcu * (NUNIT / 256);
    P4Regs R; p4_prefetch(a, u0, R);
    for (int i = 0; i < NUNIT / 256; ++i) {
        const int u = u0 + i, h = u & 3, c = (u >> 2) & (NCH - 1), b = u >> 9, r0 = b * SEQ + c * CH, seq0 = c * CH;
        LAS unsigned char* buf = lds + (i & 1) * P4_BUF;
        LAS bf16_t* KT = (LAS bf16_t*)(buf + P4_KT); LAS bf16_t* VT = (LAS bf16_t*)(buf + P4_VT); LAS bf16_t* Us = (LAS bf16_t*)(buf + P4_US);
        bf16_t* a2 = (bf16_t*)(ws + WS_A2);
        float bc = R.lf;
#pragma unroll
        for (int o = 1; o < 64; o <<= 1) { const float t = __shfl_up(bc, o); if (lane >= o) bc += t; }
        const float Bt = __shfl(bc, 63), g = Bt - bc + R.ig, ml = wave_max(g), w = __expf(g - ml);
        if (tid == 0) { ((float*)(ws + WS_UB))[u] = Bt; ((float*)(ws + WS_UM))[u] = ml; }
#pragma unroll
        for (int it = 0; it < 2; ++it) { const int dg = wave + 8 * it; float o[8];
            conv_taps(R.kt[it], cw, ZC_K + h * DH + dg * 8, o);
#pragma unroll
            for (int e = 0; e < 8; ++e) o[e] *= 0.08838834764831845f;
            u32x4 kw; kw.x = cvt_pk_bf16(o[0], o[1]); kw.y = cvt_pk_bf16(o[2], o[3]); kw.z = cvt_pk_bf16(o[4], o[5]); kw.w = cvt_pk_bf16(o[6], o[7]);
            *(u32x4*)(a2 + (size_t)(r0 + lane) * D + h * DH + dg * 8) = kw;
            const unsigned kk[4] = {kw.x, kw.y, kw.z, kw.w};
#pragma unroll
            for (int e = 0; e < 4; ++e) { KT[(dg * 8 + 2 * e) * TP + lane] = (bf16_t)(kk[e] & 0xffffu); KT[(dg * 8 + 2 * e + 1) * TP + lane] = (bf16_t)(kk[e] >> 16); } }
#pragma unroll
        for (int it = 0; it < 2; ++it) { const int vg = wave + 8 * it; float f[8]; unpack8(R.vv[it], f);
#pragma unroll
            for (int e = 0; e < 8; ++e) VT[(vg * 8 + e) * TP + lane] = f2bf(f[e] * w); }
        if (wave == 0) VT[128 * TP + lane] = f2bf(w);
#pragma unroll
        for (int it = 0; it < 3; ++it) { const int idx = tid + 512 * it, row = idx >> 4, cg = idx & 15; if (idx < 79 * 16) *(LAS u32x4*)(Us + row * QP + cg * 8) = R.uu[it]; }
        __syncthreads();
        if (i + 1 < NUNIT / 256) p4_prefetch(a, u + 1, R);
        {
            bf16_t* dc = (bf16_t*)(ws + WS_CST) + (size_t)u * DH * DH;
            const int v0 = wave * 16;
            const bf16x8 bv0 = ldfrag(VT, TP, v0 + fr, 8 * fq), bv1 = ldfrag(VT, TP, v0 + fr, 32 + 8 * fq);
            bf16x8 nv0 = bv0, nv1 = bv1; if (wave == 0) { nv0 = ldfrag(VT, TP, 128 + fr, 8 * fq); nv1 = ldfrag(VT, TP, 128 + fr, 32 + 8 * fq); }
#pragma unroll
            for (int dt = 0; dt < 8; ++dt) {
                const bf16x8 a0 = ldfrag(KT, TP, dt * 16 + fr, 8 * fq), a1 = ldfrag(KT, TP, dt * 16 + fr, 32 + 8 * fq);
                f32x4 acc = {0.f, 0.f, 0.f, 0.f};
                acc = __builtin_amdgcn_mfma_f32_16x16x32_bf16(a0, bv0, acc, 0, 0, 0);
                acc = __builtin_amdgcn_mfma_f32_16x16x32_bf16(a1, bv1, acc, 0, 0, 0);
                u32x2 wv; wv.x = cvt_pk_bf16(acc[0], acc[1]); wv.y = cvt_pk_bf16(acc[2], acc[3]);
                *(u32x2*)(dc + (size_t)(v0 + fr) * DH + dt * 16 + 4 * fq) = wv;
                if (wave == 0) { f32x4 an = {0.f, 0.f, 0.f, 0.f};
                    an = __builtin_amdgcn_mfma_f32_16x16x32_bf16(a0, nv0, an, 0, 0, 0);
                    an = __builtin_amdgcn_mfma_f32_16x16x32_bf16(a1, nv1, an, 0, 0, 0);
                    if (fr == 0) *(f32x4*)((float*)(ws + WS_NST) + (size_t)u * DH + dt * 16 + 4 * fq) = an; }
            }
        }
        {
            const int win = 2 << h;
#pragma unroll
            for (int it = 0; it < 2; ++it) { const int idx = tid + 512 * it, s = idx >> 4, cg = idx & 15, pos = seq0 + s; const int cnt = pos + 1 < win ? pos + 1 : win;
                float sum[8], cur[8]; unpack8(*(const LAS u32x4*)(Us + (s + 15) * QP + cg * 8), cur);
#pragma unroll
                for (int e = 0; e < 8; ++e) sum[e] = cur[e];
                for (int j = 1; j < win; ++j) { float f[8]; unpack8(*(const LAS u32x4*)(Us + (s + 15 - j) * QP + cg * 8), f);
#pragma unroll
                    for (int e = 0; e < 8; ++e) sum[e] += f[e]; }
                const float inv = 1.0f / (float)cnt;
                u32x4 wv; wv.x = cvt_pk_bf16(sum[0] * inv - cur[0], sum[1] * inv - cur[1]); wv.y = cvt_pk_bf16(sum[2] * inv - cur[2], sum[3] * inv - cur[3]);
                wv.z = cvt_pk_bf16(sum[4] * inv - cur[4], sum[5] * inv - cur[5]); wv.w = cvt_pk_bf16(sum[6] * inv - cur[6], sum[7] * inv - cur[7]);
                *(u32x4*)(a2 + (size_t)(r0 + s) * D + 512 + h * 128 + cg * 8) = wv; }
        }
    }
    __syncthreads();
}

struct P5Batch { u32x2 dv[8]; float dn[8], Bt[8], ml[8]; };
__device__ __forceinline__ void p5_load(const Args& a, int b, int h, int cb, int eoff, bool do_n, P5Batch& B) {
    const bf16_t* dcs = (const bf16_t*)(a.ws + WS_CST); const float* dns = (const float*)(a.ws + WS_NST);
    const float* uB = (const float*)(a.ws + WS_UB); const float* uM = (const float*)(a.ws + WS_UM);
#pragma unroll
    for (int i = 0; i < 8; ++i) { const int u = ((b * NCH + cb + i) << 2) + h;
        B.dv[i] = *(const u32x2*)(dcs + (size_t)u * DH * DH + eoff); B.dn[i] = do_n ? dns[(size_t)u * DH + threadIdx.x] : 0.f; B.Bt[i] = uB[u]; B.ml[i] = uM[u]; }
}
struct P5State { float C0, C1, C2, C3, nn, mst; };
__device__ __forceinline__ void p5_step(const Args& a, int b, int h, int cb, int eoff, bool do_n, bool do_m, const P5Batch& B, P5State& S) {
    bf16_t* cst = (bf16_t*)(a.ws + WS_CST); float* nst = (float*)(a.ws + WS_NST2); float* uMS = (float*)(a.ws + WS_UMS);
#pragma unroll
    for (int i = 0; i < 8; ++i) { const int u = ((b * NCH + cb + i) << 2) + h;
        const float mn = fmaxf(B.Bt[i] + S.mst, B.ml[i]), dec = __expf(B.Bt[i] + S.mst - mn), sc = __expf(B.ml[i] - mn);
        S.C0 = dec * S.C0 + sc * bf_lo(B.dv[i].x); S.C1 = dec * S.C1 + sc * bf_hi(B.dv[i].x); S.C2 = dec * S.C2 + sc * bf_lo(B.dv[i].y); S.C3 = dec * S.C3 + sc * bf_hi(B.dv[i].y);
        S.nn = dec * S.nn + sc * B.dn[i]; S.mst = mn;
        u32x2 w; w.x = cvt_pk_bf16(S.C0, S.C1); w.y = cvt_pk_bf16(S.C2, S.C3);
        *(u32x2*)(cst + (size_t)u * DH * DH + eoff) = w;
        if (do_n) nst[(size_t)u * DH + threadIdx.x] = S.nn;
        if (do_m) uMS[u] = mn; }
}
__device__ __forceinline__ void p5_scan(const Args& a, int wg) {
    const int tid = threadIdx.x, stream = wg >> 3, slice = wg & 7, b = stream >> 2, h = stream & 3;
    const int eoff = (slice * 16 + (tid >> 5)) * DH + (tid & 31) * 4;
    const bool do_n = (slice == 0) && (tid < 128), do_m = (slice == 0) && (tid == 0);
    P5State S{0.f, 0.f, 0.f, 0.f, 0.f, 0.f}; P5Batch A, Bb;
    p5_load(a, b, h, 0, eoff, do_n, A);
    for (int cb = 0; cb < NCH; cb += 16) {
        p5_load(a, b, h, cb + 8, eoff, do_n, Bb);
        p5_step(a, b, h, cb, eoff, do_n, do_m, A, S);
        if (cb + 16 < NCH) p5_load(a, b, h, cb + 16, eoff, do_n, A);
        p5_step(a, b, h, cb + 8, eoff, do_n, do_m, Bb, S);
    }
}

struct P6Regs { u32x4 qt[2][4]; u32x4 kc[2]; u32x4 vv[2]; u32x4 cc[4]; u32x2 so[4]; f32x4 gn; float nn, lf, ig, mp; };
constexpr int P6_Q = 0, P6_K = 17408, P6_VT = 34816, P6_C = 53248, P6_P = 88064, P6_SM = 97280, P6_CW = 101632;
__device__ __forceinline__ void p6_prefetch(const Args& a, int u, P6Regs& R) {
    const bf16_t* z = (const bf16_t*)(a.ws + WS_Z); const float* zif = (const float*)(a.ws + WS_ZIF); const bf16_t* a2 = (const bf16_t*)(a.ws + WS_A2);
    const int tid = threadIdx.x, lane = tid & 63, wave = tid >> 6, fr = lane & 15, fq = lane >> 4;
    const int h = u & 3, c = (u >> 2) & (NCH - 1), b = u >> 9, r0 = b * SEQ + c * CH, seq0 = c * CH;
    R.lf = 0.f; R.ig = 0.f; R.mp = 0.f;
    if (wave == 0) { R.lf = zif[(size_t)(r0 + lane) * 8 + 4 + h]; R.ig = zif[(size_t)(r0 + lane) * 8 + h]; if (c > 0) R.mp = ((const float*)(a.ws + WS_UMS))[u - NH]; }
#pragma unroll
    for (int it = 0; it < 2; ++it) { const int idx = tid + 512 * it, s = idx >> 4, dg = idx & 15;
        load_taps(z, r0, s, seq0, ZC_Q + h * DH + dg * 8, R.qt[it]);
        R.kc[it] = *(const u32x4*)(a2 + (size_t)(r0 + s) * D + h * DH + dg * 8); }
#pragma unroll
    for (int it = 0; it < 2; ++it) R.vv[it] = *(const u32x4*)(z + (size_t)(r0 + lane) * ZW + ZC_V + h * DH + (wave + 8 * it) * 8);
    const bf16_t* cp = (const bf16_t*)(a.ws + WS_CST) + (size_t)(u - NH) * DH * DH;
#pragma unroll
    for (int it = 0; it < 4; ++it) { const int idx = tid + 512 * it, v = idx >> 4, dg = idx & 15; R.cc[it] = (u32x4){0u, 0u, 0u, 0u}; if (c > 0) R.cc[it] = *(const u32x4*)(cp + v * DH + dg * 8); }
    R.nn = 0.f; if (c > 0 && tid < 128) R.nn = ((const float*)(a.ws + WS_NST2))[(size_t)(u - NH) * DH + tid];
#pragma unroll
    for (int tt = 0; tt < 4; ++tt) R.so[tt] = *(const u32x2*)(z + (size_t)(r0 + tt * 16 + fr) * ZW + ZC_O + h * DH + wave * 16 + 4 * fq);
    R.gn = *(const f32x4*)(a.hng + h * DH + wave * 16 + 4 * fq);
}
__device__ __forceinline__ void p6_phase(const Args& a, LAS unsigned char* lds, int vcu) {
    unsigned char* ws = a.ws;
    const int tid = threadIdx.x, lane = tid & 63, wave = tid >> 6, fr = lane & 15, fq = lane >> 4;
    LAS bf16_t* Qs = (LAS bf16_t*)(lds + P6_Q); LAS bf16_t* Ks = (LAS bf16_t*)(lds + P6_K); LAS bf16_t* VT = (LAS bf16_t*)(lds + P6_VT);
    LAS bf16_t* Cs = (LAS bf16_t*)(lds + P6_C); LAS bf16_t* Ps = (LAS bf16_t*)(lds + P6_P);
    LAS float* sN = (LAS float*)(lds + P6_SM); LAS float* sWi = sN + 128; LAS float* sRt = sWi + 64; LAS float* sE = sRt + 64; LAS float* sFl = sE + 64;
    LAS float* rsum = sFl + 64; LAS float* nqs = rsum + 128; LAS float* ssqp = nqs + 64;
    LAS float* cw = (LAS float*)(lds + P6_CW);
#pragma unroll
    for (int it = 0; it < 2; ++it) *(LAS f32x4*)(cw + (tid + 512 * it) * 4) = *(const f32x4*)(a.convw + (tid + 512 * it) * 4);
    __syncthreads();
    const int u0 = vcu * (NUNIT / 256);
    P6Regs R; p6_prefetch(a, u0, R);
    for (int i = 0; i < NUNIT / 256; ++i) {
        const int u = u0 + i, h = u & 3, c = (u >> 2) & (NCH - 1), b = u >> 9, r0 = b * SEQ + c * CH;
        bf16_t* a2 = (bf16_t*)(ws + WS_A2);
        if (wave == 0) {
            float bc = R.lf;
#pragma unroll
            for (int o = 1; o < 64; o <<= 1) { const float t = __shfl_up(bc, o); if (lane >= o) bc += t; }
            const float e = R.ig - bc; float cm = e;
#pragma unroll
            for (int o = 1; o < 64; o <<= 1) { const float t = __shfl_up(cm, o); if (lane >= o) cm = fmaxf(cm, t); }
            const float ai = bc + R.mp, mt = fmaxf(ai, bc + cm);
            sWi[lane] = __expf(ai - mt); sRt[lane] = bc - mt; sE[lane] = e; sFl[lane] = __expf(-mt);
        }
#pragma unroll
        for (int it = 0; it < 2; ++it) { const int idx = tid + 512 * it, s = idx >> 4, dg = idx & 15; float o[8];
            conv_taps(R.qt[it], cw, ZC_Q + h * DH + dg * 8, o);
            u32x4 w; w.x = cvt_pk_bf16(o[0], o[1]); w.y = cvt_pk_bf16(o[2], o[3]); w.z = cvt_pk_bf16(o[4], o[5]); w.w = cvt_pk_bf16(o[6], o[7]);
            *(LAS u32x4*)(Qs + s * QP + dg * 8) = w;
            *(LAS u32x4*)(Ks + s * QP + dg * 8) = R.kc[it]; }
#pragma unroll
        for (int it = 0; it < 2; ++it) { const int vg = wave + 8 * it; const unsigned wv[4] = {R.vv[it].x, R.vv[it].y, R.vv[it].z, R.vv[it].w};
#pragma unroll
            for (int e = 0; e < 4; ++e) { VT[(vg * 8 + 2 * e) * TP + lane] = (bf16_t)(wv[e] & 0xffffu); VT[(vg * 8 + 2 * e + 1) * TP + lane] = (bf16_t)(wv[e] >> 16); } }
#pragma unroll
        for (int it = 0; it < 4; ++it) { const int idx = tid + 512 * it, v = idx >> 4, dg = idx & 15; *(LAS u32x4*)(Cs + v * QP + dg * 8) = R.cc[it]; }
        if (tid < 128) sN[tid] = R.nn;
        const u32x2 so0 = R.so[0], so1 = R.so[1], so2 = R.so[2], so3 = R.so[3]; const f32x4 gn = R.gn;
        __syncthreads();
        if (i + 1 < NUNIT / 256) p6_prefetch(a, u + 1, R);
        {
            const int t0 = (wave & 3) * 16, t = t0 + fr;
            bf16x8 qf[4];
#pragma unroll
            for (int kk = 0; kk < 4; ++kk) qf[kk] = ldfrag(Qs, QP, t, 32 * kk + 8 * fq);
            const float rt = sRt[t]; float ps = 0.f;
#pragma unroll
            for (int i2 = 0; i2 < 2; ++i2) { const int s0 = ((wave >> 2) * 2 + i2) * 16;
                f32x4 acc = {0.f, 0.f, 0.f, 0.f};
#pragma unroll
                for (int kk = 0; kk < 4; ++kk) acc = __builtin_amdgcn_mfma_f32_16x16x32_bf16(ldfrag(Ks, QP, s0 + fr, 32 * kk + 8 * fq), qf[kk], acc, 0, 0, 0);
                float p[4];
#pragma unroll
                for (int j = 0; j < 4; ++j) { const int s = s0 + 4 * fq + j; p[j] = s <= t ? acc[j] * __expf(rt + sE[s]) : 0.f; }
                u32x2 w; w.x = cvt_pk_bf16(p[0], p[1]); w.y = cvt_pk_bf16(p[2], p[3]);
                *(LAS u32x2*)(Ps + t * TP + s0 + 4 * fq) = w;
                ps += (bf_lo(w.x) + bf_hi(w.x)) + (bf_lo(w.y) + bf_hi(w.y)); }
            ps += __shfl_xor(ps, 16); ps += __shfl_xor(ps, 32);
            if (fq == 0) rsum[t * 2 + (wave >> 2)] = ps;
            const int t2 = tid >> 3, part = tid & 7; float nq = 0.f;
#pragma unroll
            for (int d = 0; d < 16; ++d) nq += sN[part * 16 + d] * __uint_as_float((unsigned)Qs[t2 * QP + part * 16 + d] << 16);
            nq += __shfl_xor(nq, 1); nq += __shfl_xor(nq, 2); nq += __shfl_xor(nq, 4);
            if (part == 0) nqs[t2] = nq;
        }
        __syncthreads();
        f32x4 hv[4];
        {
            const int v0 = wave * 16;
            bf16x8 cf[4], vf[2];
#pragma unroll
            for (int kk = 0; kk < 4; ++kk) cf[kk] = ldfrag(Cs, QP, v0 + fr, 32 * kk + 8 * fq);
#pragma unroll
            for (int kk = 0; kk < 2; ++kk) vf[kk] = ldfrag(VT, TP, v0 + fr, 32 * kk + 8 * fq);
#pragma unroll
            for (int tt = 0; tt < 4; ++tt) { const int t = tt * 16 + fr;
                f32x4 ai = {0.f, 0.f, 0.f, 0.f}, ap = {0.f, 0.f, 0.f, 0.f};
#pragma unroll
                for (int kk = 0; kk < 4; ++kk) ai = __builtin_amdgcn_mfma_f32_16x16x32_bf16(cf[kk], ldfrag(Qs, QP, t, 32 * kk + 8 * fq), ai, 0, 0, 0);
#pragma unroll
                for (int kk = 0; kk < 2; ++kk) ap = __builtin_amdgcn_mfma_f32_16x16x32_bf16(vf[kk], ldfrag(Ps, TP, t, 32 * kk + 8 * fq), ap, 0, 0, 0);
                const float wi = sWi[t], den = wi * nqs[t] + (rsum[2 * t] + rsum[2 * t + 1]), inv = 1.0f / fmaxf(fabsf(den), sFl[t]);
                hv[tt] = (ai * wi + ap) * inv;
                float q = (hv[tt][0] * hv[tt][0] + hv[tt][1] * hv[tt][1]) + (hv[tt][2] * hv[tt][2] + hv[tt][3] * hv[tt][3]);
                q += __shfl_xor(q, 16); q += __shfl_xor(q, 32);
                if (fq == 0) ssqp[t * 8 + wave] = q; }
        }
        __syncthreads();
        {
            const u32x2 sov[4] = {so0, so1, so2, so3};
#pragma unroll
            for (int tt = 0; tt < 4; ++tt) { const int t = tt * 16 + fr;
                const f32x4 q0 = *(const LAS f32x4*)(ssqp + t * 8), q1 = *(const LAS f32x4*)(ssqp + t * 8 + 4);
                const float rn = __builtin_amdgcn_rsqf(((q0[0] + q0[1]) + (q0[2] + q0[3]) + (q1[0] + q1[1]) + (q1[2] + q1[3])) * (1.0f / DH) + EPS);
                u32x2 w; w.x = cvt_pk_bf16(hv[tt][0] * rn * gn[0] * bf_lo(sov[tt].x), hv[tt][1] * rn * gn[1] * bf_hi(sov[tt].x));
                w.y = cvt_pk_bf16(hv[tt][2] * rn * gn[2] * bf_lo(sov[tt].y), hv[tt][3] * rn * gn[3] * bf_hi(sov[tt].y));
                *(u32x2*)(a2 + (size_t)(r0 + t) * D + h * DH + wave * 16 + 4 * fq) = w; }
        }
    }
    __syncthreads();
}

__device__ __forceinline__ void p_final(const Args& a, int gw, int NGW, int lane) {
    const f32x4* gp = (const f32x4*)a.fng + lane; f32x4 g[4];
#pragma unroll
    for (int j = 0; j < 4; ++j) g[j] = gp[64 * j];
    for (int m = gw; m < M; m += NGW) {
        f32x4* xr = (f32x4*)(a.out + (size_t)m * D) + lane; f32x4 v[4]; float s = 0.f;
#pragma unroll
        for (int j = 0; j < 4; ++j) { v[j] = xr[64 * j]; s += (v[j][0] * v[j][0] + v[j][1] * v[j][1]) + (v[j][2] * v[j][2] + v[j][3] * v[j][3]); }
        const float r = __builtin_amdgcn_rsqf(wave_sum(s) * (1.0f / D) + EPS);
#pragma unroll
        for (int j = 0; j < 4; ++j) xr[64 * j] = v[j] * r * g[j];
    }
}

__global__ void __launch_bounds__(512, 2) fwd_kernel(Args a) {
    extern __shared__ __attribute__((aligned(16))) unsigned char lds_raw[];
    LAS unsigned char* lds = (LAS unsigned char*)lds_raw;
    volatile LAS unsigned* MISC = (volatile LAS unsigned*)(lds + MISC_OFF);
    const int tid = threadIdx.x, lane = tid & 63, wave = __builtin_amdgcn_readfirstlane(tid >> 6);
    const int G = gridDim.x, bx = blockIdx.x;
    const int vcu = (G % 8 == 0) ? (bx % 8) * (G / 8) + bx / 8 : bx;
    const int gw = vcu * 8 + wave, NGW = G * 8;
    unsigned char* ws = a.ws;
    if (tid < 32) MISC[tid] = 0u;
    __syncthreads();
    XcdBarrier bar; bar.bar = (unsigned*)(ws + WS_CTL) + CW_BAR; bar.x = 0; bar.st = nullptr;
    if (MK_N_LAUNCHES == 1) bar = xcd_barrier_post((unsigned*)(ws + WS_CTL) + CW_BAR, MISC + 8);
    const int lo = a.ph_lo, hi = a.ph_hi;
#define IN(k) (lo <= (k) && (k) < hi)
#if PROBE_TIME
    unsigned long long tph = __builtin_amdgcn_s_memrealtime();
#define SEAM(k) do { if (IN(k) && IN((k) + 1)) xcd_barrier(bar); { const unsigned long long tn = __builtin_amdgcn_s_memrealtime(); if ((k) == PROBE_PHASE) tprobe = tn - tph; tph = tn; } } while (0)
#else
#define SEAM(k) do { if (IN(k) && IN((k) + 1)) xcd_barrier(bar); } while (0)
#endif
    bf16_t* const HB = (bf16_t*)(ws + WS_H); bf16_t* const A2 = (bf16_t*)(ws + WS_A2); bf16_t* const MG = (bf16_t*)(ws + WS_CST); bf16_t* const ZB = (bf16_t*)(ws + WS_Z); bf16_t* const ACT = ZB;
    float* const SS = (float*)(ws + WS_SS);
    LAS float* const EP = (LAS float*)(lds + EPI_OFF);

    unsigned long long tprobe = 0ull;
    if (IN(0)) { p0_prologue(a, lds, gw, NGW, lane, wave); }
    SEAM(0);
    if (IN(1)) {
        pg8::Gemm g{HB, (const bf16_t*)(ws + WS_WGU1), M, NGU, D, D, D}; pg8::StaticOrder S; S.init(M, NGU, G, bx);
        pg8::EpiSwiGLU<false> E{ACT, SS};
        pg8::gemm_phase<pg8::EpiSwiGLU<false>, true>(lds, g, S, E);
    }
    SEAM(1);
    if (IN(2)) {
        pg8::Gemm g{ACT, (const bf16_t*)(ws + WS_WDN1), M, D, DFF, DFF, DFF}; pg8::StaticOrder S; S.init(M, D, G, bx);
        pg8::EpiResid<false, true> E{a.x, HB, SS, 0.5f, EP}; pg8::gemm_phase<pg8::EpiResid<false, true>, true>(lds, g, S, E);
    }
    SEAM(2);
#if EN_MIX
    if (IN(3)) {
        pg8::Gemm g{HB, (const bf16_t*)(ws + WS_WIN), M, NIN, D, D, D}; pg8::StaticOrder S; S.init(M, NIN, G, bx);
        pg8::EpiWin E{ZB, (float*)(ws + WS_ZIF), a.bin, SS}; pg8::gemm_phase<pg8::EpiWin, true>(lds, g, S, E);
    }
    SEAM(3);
    if (IN(4)) { p4_phase(a, lds, vcu); if (PROBE_DUP4) p4_phase(a, lds, vcu); }
    SEAM(4);
    if (IN(5) && EN_MLSTM) { p5_scan(a, vcu); if (PROBE_DUP5) p5_scan(a, vcu); }
    SEAM(5);
    if (IN(6) && EN_MLSTM) { p6_phase(a, lds, vcu); }
    SEAM(6);
    if (IN(7)) {
#if EN_MLSTM
        { pg8::Gemm g{A2, (const bf16_t*)(ws + WS_WAB), M, D, 512, D, D}; pg8::StaticOrder S; S.init(M, D, G, bx);
          pg8::EpiMerge<false> E{MG, ZB, ZC_GA}; pg8::gemm_phase<pg8::EpiMerge<false>, true>(lds, g, S, E); }
        { pg8::Gemm g{A2 + 512, (const bf16_t*)(ws + WS_WAB) + 512, M, D, 512, D, D}; pg8::StaticOrder S; S.init(M, D, G, bx);
          pg8::EpiMerge<true> E{MG, ZB, ZC_GB}; pg8::gemm_phase<pg8::EpiMerge<true>, true>(lds, g, S, E); }
#else
        { pg8::Gemm g{A2 + 512, (const bf16_t*)(ws + WS_WAB) + 512, M, D, 512, D, D}; pg8::StaticOrder S; S.init(M, D, G, bx);
          pg8::EpiMerge<false> E{MG, ZB, ZC_GB}; pg8::gemm_phase<pg8::EpiMerge<false>, true>(lds, g, S, E); }
#endif
    }
    SEAM(7);
    if (IN(8)) {
        pg8::Gemm g{MG, (const bf16_t*)(ws + WS_WOUT), M, D, D, D, D}; pg8::StaticOrder S; S.init(M, D, G, bx);
        pg8::EpiResid<true, true> E{HB, A2, SS, 1.0f, EP}; pg8::gemm_phase<pg8::EpiResid<true, true>, true>(lds, g, S, E);
    }
    SEAM(8);
#else
    SEAM(3); SEAM(4); SEAM(5); SEAM(6); SEAM(7); SEAM(8);
#endif
#if EN_FFN2
    if (IN(9)) {
        pg8::Gemm g{A2, (const bf16_t*)(ws + WS_WGU2), M, NGU, D, D, D}; pg8::StaticOrder S; S.init(M, NGU, G, bx);
        pg8::EpiSwiGLU<true> E{ACT, SS}; pg8::gemm_phase<pg8::EpiSwiGLU<true>, true>(lds, g, S, E);
    }
    SEAM(9);
    if (IN(10)) {
        pg8::Gemm g{ACT, (const bf16_t*)(ws + WS_WDN2), M, D, DFF, DFF, DFF}; pg8::StaticOrder S; S.init(M, D, G, bx);
        pg8::EpiResid<true, false> E{A2, a.out, nullptr, 0.5f, EP}; pg8::gemm_phase<pg8::EpiResid<true, false>, true>(lds, g, S, E);
    }
    SEAM(10);
#else
    SEAM(9); SEAM(10);
#endif
    if (IN(11)) { p_final(a, gw, NGW, lane); }
#if PROBE_TIME
    if (PROBE_PHASE == 11) { __syncthreads(); tprobe = __builtin_amdgcn_s_memrealtime() - tph; }
    if (bx == 0 && wave == 0) { const unsigned long long t0 = __builtin_amdgcn_s_memrealtime(); while (__builtin_amdgcn_s_memrealtime() - t0 < tprobe) __builtin_amdgcn_s_sleep(8); }
#endif
#undef IN
#undef SEAM
}

extern "C" void kernel_launch(void* const* d_in, const int* in_sizes, int n_in, void* d_out, int out_size, void* d_ws, size_t ws_size, hipStream_t stream) {
    static int grid = 0;
    if (grid == 0) {
        if (n_in != 18 || in_sizes[0] != M * D || out_size != M * D || ws_size < WS_END) { fprintf(stderr, "kernel_launch: unexpected problem (n_in %d, in0 %d, out %d, ws %zu)\n", n_in, n_in > 0 ? in_sizes[0] : -1, out_size, ws_size); grid = -1; return; }
        int dev = 0, cus = 0, per_cu = 0;
        if (hipGetDevice(&dev) != hipSuccess || hipDeviceGetAttribute(&cus, hipDeviceAttributeMultiprocessorCount, dev) != hipSuccess) { grid = -1; return; }
        if (hipFuncSetAttribute((const void*)fwd_kernel, hipFuncAttributeMaxDynamicSharedMemorySize, LDS_BYTES) != hipSuccess) { fprintf(stderr, "kernel_launch: hipFuncSetAttribute failed\n"); grid = -1; return; }
        if (hipOccupancyMaxActiveBlocksPerMultiprocessor(&per_cu, (const void*)fwd_kernel, 512, LDS_BYTES) != hipSuccess || per_cu < 1) { fprintf(stderr, "kernel_launch: occupancy query reports %d\n", per_cu); }
        (void)hipGetLastError();
        grid = cus;
        if (grid != 256) { fprintf(stderr, "kernel_launch: %d CUs; this kernel is laid out for 256\n", grid); grid = -1; return; }
    }
    if (grid < 0) return;
    if (hipMemsetAsync((char*)d_ws + WS_CTL, 0, CTL_ZERO_BYTES, stream) != hipSuccess) return;
    Args a{};
    a.x = (const float*)d_in[0]; a.n1g = (const float*)d_in[1]; a.wgu1 = (const float*)d_in[2]; a.wdn1 = (const float*)d_in[3]; a.mng = (const float*)d_in[4];
    a.win = (const float*)d_in[5]; a.bin = (const float*)d_in[6]; a.convw = (const float*)d_in[7]; a.hng = (const float*)d_in[8]; a.pa = (const float*)d_in[9];
    a.wpool = (const float*)d_in[10]; a.pscale = (const float*)d_in[11]; a.pb = (const float*)d_in[12]; a.wout = (const float*)d_in[13]; a.n2g = (const float*)d_in[14];
    a.wgu2 = (const float*)d_in[15]; a.wdn2 = (const float*)d_in[16]; a.fng = (const float*)d_in[17];
    a.out = (float*)d_out; a.ws = (unsigned char*)d_ws;
    if (MK_N_LAUNCHES == 1) { a.ph_lo = 0; a.ph_hi = NPHASE; hipLaunchKernelGGL(fwd_kernel, dim3(grid), dim3(512), LDS_BYTES, stream, a); }
    else for (int p = 0; p < NPHASE; ++p) { a.ph_lo = p; a.ph_hi = p + 1; hipLaunchKernelGGL(fwd_kernel, dim3(grid), dim3(512), LDS_BYTES, stream, a); }
}
```

```cpp
#include <hip/hip_runtime.h>
#include <cstdio>

#ifndef MK_N_LAUNCHES
#define MK_N_LAUNCHES 1
#endif
#define LAS __attribute__((address_space(3)))
#define GAS __attribute__((address_space(1)))
typedef unsigned short bf16_t;
typedef short bf16x8 __attribute__((ext_vector_type(8)));
typedef float f32x4 __attribute__((ext_vector_type(4)));
typedef float f32x2 __attribute__((ext_vector_type(2)));
typedef unsigned u32x4 __attribute__((ext_vector_type(4)));
typedef unsigned u32x2 __attribute__((ext_vector_type(2)));
typedef GAS unsigned gu32;

constexpr int BATCH = 8, SEQ = 8192, D = 1024, M = BATCH * SEQ, DFF = 2816, NGU = 2 * DFF;
constexpr int NH = 4, DH = 128, CH = 64, NCH = SEQ / CH, NUNIT = BATCH * NCH * NH;
constexpr int DIN = 4616, NIN = 4864, ZW = 4608;
constexpr int ZC_Q = 0, ZC_K = 512, ZC_V = 1024, ZC_O = 1536, ZC_U = 2048, ZC_GA = 2560, ZC_GB = 3584;
constexpr float EPS = 1e-6f;
constexpr int NPHASE = 12;

constexpr size_t MiB = 1u << 20;
constexpr size_t WS_CTL = 0, CTL_ZERO_BYTES = 1 * MiB;
constexpr size_t WS_WGU1 = 1 * MiB;
constexpr size_t WS_WDN1 = WS_WGU1 + (size_t)NGU * D * 2;
constexpr size_t WS_WIN = WS_WDN1 + (size_t)D * DFF * 2;
constexpr size_t WS_WAB = WS_WIN + (size_t)NIN * D * 2;
constexpr size_t WS_WOUT = WS_WAB + (size_t)D * D * 2;
constexpr size_t WS_WGU2 = WS_WOUT + (size_t)D * D * 2;
constexpr size_t WS_WDN2 = WS_WGU2 + (size_t)NGU * D * 2;
constexpr size_t WS_WEND = WS_WDN2 + (size_t)D * DFF * 2;
constexpr size_t WS_SS = 48 * MiB;
constexpr size_t WS_ZIF = 49 * MiB;
constexpr size_t WS_NST = 51 * MiB;
constexpr size_t WS_UB = 53 * MiB, WS_UM = WS_UB + 65536, WS_UMS = WS_UM + 65536;
constexpr size_t WS_NST2 = 54 * MiB;
constexpr size_t WS_H = 64 * MiB;
constexpr size_t WS_A2 = 192 * MiB;
constexpr size_t WS_CST = 320 * MiB;
constexpr size_t WS_Z = 448 * MiB;
constexpr size_t WS_END = 1024 * MiB;
static_assert(WS_WEND <= WS_SS && WS_Z + (size_t)M * ZW * 2 <= WS_END && WS_CST + (size_t)NUNIT * DH * DH * 2 <= WS_Z, "ws map");
constexpr int CW_TMO = 0, CW_BAR = 4096;

constexpr int RING_BYTES = 131072, EPI_OFF = RING_BYTES, EPI_BYTES = 4096, LDS_BYTES = 147456, MISC_OFF = LDS_BYTES - 256;

#define RLX_AGENT __ATOMIC_RELAXED, __HIP_MEMORY_SCOPE_AGENT
typedef __bf16 bf16x2_t __attribute__((ext_vector_type(2)));
__device__ __forceinline__ unsigned cvt_pk_bf16(float lo, float hi) { const f32x2 v = {lo, hi}; return __builtin_bit_cast(unsigned, __builtin_convertvector(v, bf16x2_t)); }
__device__ __forceinline__ bf16_t f2bf_s(float x) { return (bf16_t)(cvt_pk_bf16(x, 0.f) & 0xffffu); }
__device__ __forceinline__ float bf_lo(unsigned w) { return __uint_as_float(w << 16); }
__device__ __forceinline__ float bf_hi(unsigned w) { return __uint_as_float(w & 0xffff0000u); }
__device__ __forceinline__ float fast_exp(float x) { return __builtin_amdgcn_exp2f(x * 1.44269504089f); }
__device__ __forceinline__ float fast_sigmoid(float x) { return __builtin_amdgcn_rcpf(1.0f + fast_exp(-x)); }

#define XB_TMO      128
#define XB_XCNT(j)  (256  + 64 * (j))
#define XB_XSUB(j)  (1280 + 64 * (j))
#define XB_XGEN(j)  (2304 + 64 * (j))
#define XB_TOP      3328
#define XB_TOPGEN   3392
#define XCD_BAR_WORDS 3456
#define XB_SPIN_CAP (1u << 18)
__device__ __forceinline__ unsigned xb_ld(unsigned* p)              { return __hip_atomic_load(p, __ATOMIC_RELAXED, __HIP_MEMORY_SCOPE_AGENT); }
__device__ __forceinline__ unsigned xb_add(unsigned* p, unsigned v) { return __hip_atomic_fetch_add(p, v, __ATOMIC_RELAXED, __HIP_MEMORY_SCOPE_AGENT); }
__device__ __forceinline__ unsigned xb_xcc_id() { return (unsigned)__builtin_amdgcn_s_getreg((3 << 11) | 20) & 0xFu; }
#define XB_SPIN(cond, bar) do { unsigned _sp = 0; while (cond) { __builtin_amdgcn_s_sleep(1); \
    if ((++_sp & 255u) == 0u) { if (xb_ld(&(bar)[XB_TMO])) break; if (_sp > XB_SPIN_CAP) { atomicAdd(&(bar)[XB_TMO], 1u); break; } } } } while (0)
struct XcdBarrier { unsigned* bar; unsigned x; volatile LAS unsigned* st; };
__device__ __forceinline__ XcdBarrier xcd_barrier_post(unsigned* bar, volatile LAS unsigned* st) {
    XcdBarrier b; b.bar = bar; b.x = xb_xcc_id(); b.st = st;
    if (threadIdx.x == 0) (void)xb_add(&bar[XB_XCNT(b.x)], 1u);
    return b;
}
__device__ __forceinline__ void xcd_barrier_complete(unsigned* bar, unsigned x, unsigned& nloc, unsigned& nx) {
    const unsigned G = gridDim.x * gridDim.y * gridDim.z;
    unsigned sum, cnt, mine, sp = 0u;
    for (;;) {
        sum = 0u; cnt = 0u; mine = 0u;
#pragma unroll
        for (unsigned j = 0; j < 16; ++j) { const unsigned c = xb_ld(&bar[XB_XCNT(j)]); sum += c; cnt += (c > 0u) ? 1u : 0u; mine = (j == x) ? c : mine; }
        if (sum == G) break;
        __builtin_amdgcn_s_sleep(1);
        if ((++sp & 255u) == 0u) { if (xb_ld(&bar[XB_TMO])) break; if (sp > XB_SPIN_CAP) { atomicAdd(&bar[XB_TMO], 1u); break; } }
    }
    nloc = mine > 0u ? mine : 1u; nx = cnt > 0u ? cnt : 1u;
}
__device__ __forceinline__ void xcd_barrier(const XcdBarrier& b) {
    asm volatile("s_waitcnt vmcnt(0)" ::: "memory");
    __syncthreads();
    if (threadIdx.x == 0) {
        unsigned* bar = b.bar;
        __builtin_amdgcn_s_waitcnt(0);
        unsigned nloc = b.st[0], nx = b.st[1];
        if (nloc == 0u) { xcd_barrier_complete(bar, b.x, nloc, nx); b.st[0] = nloc; b.st[1] = nx; }
        const unsigned old = xb_add(&bar[XB_XSUB(b.x)], 1u);
        const unsigned gen = old / nloc;
        if (old + 1u == (gen + 1u) * nloc) {
            __builtin_amdgcn_fence(__ATOMIC_RELEASE, "agent");
            asm volatile("s_waitcnt vmcnt(0)" ::: "memory");
            const unsigned og = xb_add(&bar[XB_TOP], 1u);
            const unsigned tg = og / nx;
            if (og + 1u == (tg + 1u) * nx) xb_add(&bar[XB_TOPGEN], 1u);
            else XB_SPIN(xb_ld(&bar[XB_TOPGEN]) == tg, bar);
            __builtin_amdgcn_fence(__ATOMIC_ACQUIRE, "agent");
            xb_add(&bar[XB_XGEN(b.x)], 1u);
            asm volatile("s_waitcnt vmcnt(0)" ::: "memory");
        } else {
            XB_SPIN(xb_ld(&bar[XB_XGEN(b.x)]) == gen, bar);
            __builtin_amdgcn_fence(__ATOMIC_ACQUIRE, "agent");
            asm volatile("s_waitcnt vmcnt(0)" ::: "memory");
        }
    }
    __syncthreads();
}

namespace pg8 {
constexpr int BM = 256, BK = 64, HALF = 128, HTB = HALF * BK * 2, STAGE_BYTES = 8 * HTB, NXCD = 8, WGM = 4;
__host__ __device__ __forceinline__ int lds_byte(int r, int c) { const int st = (r >> 4) * 2 + (c >> 5), rr = r & 15, cc = c & 31, ob = rr * 64 + cc * 2; return st * 1024 + (ob ^ (((ob >> 9) & 1) << 5)); }
__host__ __device__ __forceinline__ void stage_rc(int b, int& R, int& C) { const int st = b / 1024, sb = b % 1024, swz = sb ^ (((sb >> 9) & 1) << 5); R = (st >> 1) * 16 + swz / 64; C = (st & 1) * 32 + (swz % 64) / 2; }
__host__ __device__ __forceinline__ int perm32(int rho) { const int n = rho >> 4, i = rho & 15; return 8 * (i >> 2) + 4 * n + (i & 3); }
struct Unit { int pm, pn; };
struct Gemm { const bf16_t* A; const bf16_t* Bt; int M, N, K, lda, ldb; };
struct StaticOrder {
    int nM, nN, nwg, G, c;
    __host__ __device__ void init(int M_, int N_, int G_, int c_) { nM = M_ / BM; nN = N_ / BM; nwg = nM * nN; G = G_; c = c_; }
    __host__ __device__ bool next(int i, Unit& u) const {
        const long L = (long)i * G + c; if (L >= nwg) return false;
        int wgid = (int)L; { const int q = nwg / NXCD, r = nwg % NXCD, xcd = wgid % NXCD, off = wgid / NXCD; wgid = (xcd < r ? xcd * (q + 1) : r * (q + 1) + (xcd - r) * q) + off; }
        const int nig = WGM * nN, gid = wgid / nig, fm = gid * WGM, gsz = (nM - fm) < WGM ? (nM - fm) : WGM;
        u.pm = fm + ((wgid % nig) % gsz); u.pn = (wgid % nig) / gsz; return true;
    }
};
template <class Epi, bool ALIGN_EPI>
__device__ __forceinline__ void gemm_phase(LAS unsigned char* lds, const Gemm g, const StaticOrder& S, const Epi& E) {
    const int tid = threadIdx.x, wid = __builtin_amdgcn_readfirstlane(tid >> 6), lane = tid & 63, wr = wid >> 2, wc = wid & 3, fr = lane & 15, fq = lane >> 4;
    const int K = g.K, nt = K / BK;
    unsigned voffA[2], voffB[2];
#pragma unroll
    for (int i = 0; i < 2; ++i) { int R, C; stage_rc(tid * 16 + i * 8192, R, C); const int Rb = (R & ~31) + perm32(R & 31);
        voffA[i] = (unsigned)(R * g.lda + C) * 2u; voffB[i] = (unsigned)(Rb * g.ldb + C) * 2u; }
    const size_t kstep = (size_t)(BK * 2);
    const size_t hstepA = (size_t)HALF * g.lda * 2, hstepB = (size_t)HALF * g.ldb * 2;
    const size_t tstepA = 2 * hstepA, tstepB = 2 * hstepB;
    const unsigned ldsw = (unsigned)wid * 1024u;
    const int aoff = lds_byte(wr * 64 + fr, fq * 8), boff = lds_byte(wc * 32 + fr, fq * 8);
#define PG8_SA(b, h) (((b) * 2 + (h)) * HTB)
#define PG8_SB(b, h) ((4 + (b) * 2 + (h)) * HTB)
#define PG8_STAGE(bufoff, gbase, voff) do { _Pragma("unroll") for (int _i = 0; _i < 2; ++_i) \
        __builtin_amdgcn_global_load_lds((const unsigned*)((const char*)(gbase) + (voff)[_i]), (LAS unsigned*)(lds + (bufoff) + ldsw + _i * 8192), 16, 0, 0); } while (0)
#define PG8_LDA(dst, b, h) do { _Pragma("unroll") for (int m = 0; m < 4; ++m) _Pragma("unroll") for (int k = 0; k < 2; ++k) dst[m][k] = *(const LAS bf16x8*)(lds + PG8_SA(b, h) + aoff + m * 2048 + k * 1024); } while (0)
#define PG8_LDB(dst, b, h) do { _Pragma("unroll") for (int n = 0; n < 2; ++n) _Pragma("unroll") for (int k = 0; k < 2; ++k) dst[n][k] = *(const LAS bf16x8*)(lds + PG8_SB(b, h) + boff + n * 2048 + k * 1024); } while (0)
#define PG8_MMA(ai, bj, At, Bt) do { __builtin_amdgcn_s_setprio(1); _Pragma("unroll") for (int m = 0; m < 4; ++m) _Pragma("unroll") for (int n = 0; n < 2; ++n) _Pragma("unroll") for (int k = 0; k < 2; ++k) \
        acc[ai][bj][m][n] = __builtin_amdgcn_mfma_f32_16x16x32_bf16(Bt[n][k], At[m][k], acc[ai][bj][m][n], 0, 0, 0); __builtin_amdgcn_s_setprio(0); } while (0)
#define PG8_WAIT_V(n) asm volatile("s_waitcnt vmcnt(" #n ")" ::: "memory")
#define PG8_WAIT_L(n) asm volatile("s_waitcnt lgkmcnt(" #n ")" ::: "memory")
#define PG8_BAR __builtin_amdgcn_s_barrier()
#define PG8_SCHED __builtin_amdgcn_sched_barrier(0)
    Unit cur, nxt; int ui = 0;
    if (!S.next(0, cur)) return;
    f32x4 acc[2][2][4][2];
#pragma unroll
    for (int a = 0; a < 2; ++a)
#pragma unroll
        for (int b = 0; b < 2; ++b)
#pragma unroll
            for (int m = 0; m < 4; ++m)
#pragma unroll
                for (int n = 0; n < 2; ++n) acc[a][b][m][n] = (f32x4){0.f, 0.f, 0.f, 0.f};
    bf16x8 At[4][2], B0[2][2], B1[2][2];
    const char* cA = (const char*)g.A + (size_t)cur.pm * tstepA; const char* cB = (const char*)g.Bt + (size_t)cur.pn * tstepB;
    PG8_STAGE(PG8_SB(0, 0), cB, voffB); PG8_STAGE(PG8_SB(0, 1), cB + hstepB, voffB); PG8_STAGE(PG8_SA(0, 0), cA, voffA); PG8_STAGE(PG8_SA(0, 1), cA + hstepA, voffA);
    if (wr == 1) PG8_BAR;
    PG8_WAIT_V(2); PG8_BAR;
    PG8_STAGE(PG8_SB(1, 0), cB + kstep, voffB); PG8_STAGE(PG8_SA(1, 0), cA + kstep, voffA); PG8_STAGE(PG8_SB(1, 1), cB + hstepB + kstep, voffB);
    PG8_WAIT_V(6); PG8_BAR;
    for (;;) {
        const bool has_next = S.next(ui + 1, nxt);
        const char* nA = has_next ? (const char*)g.A + (size_t)nxt.pm * tstepA : cA; const char* nB = has_next ? (const char*)g.Bt + (size_t)nxt.pn * tstepB : cB;
        for (int t = 0; t < nt; t += 2) {
            const bool last = (t == nt - 2);
            const char* a1 = cA + (size_t)(t + 1) * kstep;
            const char* a2 = last ? nA : cA + (size_t)(t + 2) * kstep; const char* b2 = last ? nB : cB + (size_t)(t + 2) * kstep;
            const char* a3 = a2 + kstep; const char* b3 = b2 + kstep;
            PG8_LDB(B0, 0, 0); PG8_LDB(B1, 0, 1); PG8_SCHED; PG8_LDA(At, 0, 0); PG8_STAGE(PG8_SA(1, 1), a1 + hstepA, voffA);
            PG8_WAIT_V(8); PG8_WAIT_L(0); PG8_BAR; PG8_MMA(0, 0, At, B0); PG8_MMA(0, 1, At, B1); PG8_BAR; PG8_SCHED;
            PG8_LDA(At, 0, 1); PG8_STAGE(PG8_SB(0, 0), b2, voffB); PG8_STAGE(PG8_SB(0, 1), b2 + hstepB, voffB); PG8_STAGE(PG8_SA(0, 0), a2, voffA);
            PG8_WAIT_V(8); PG8_WAIT_L(0); PG8_BAR; PG8_MMA(1, 0, At, B0); PG8_MMA(1, 1, At, B1); PG8_BAR; PG8_SCHED;
            PG8_LDB(B0, 1, 0); PG8_LDB(B1, 1, 1); PG8_SCHED; PG8_LDA(At, 1, 0); PG8_STAGE(PG8_SA(0, 1), a2 + hstepA, voffA);
            PG8_WAIT_V(8); PG8_WAIT_L(0); PG8_BAR; PG8_MMA(0, 0, At, B0); PG8_MMA(0, 1, At, B1); PG8_BAR; PG8_SCHED;
            PG8_LDA(At, 1, 1); PG8_STAGE(PG8_SB(1, 0), b3, voffB); PG8_STAGE(PG8_SB(1, 1), b3 + hstepB, voffB); PG8_STAGE(PG8_SA(1, 0), a3, voffA);
            PG8_WAIT_V(8); PG8_WAIT_L(0); PG8_BAR; PG8_MMA(1, 0, At, B0); PG8_MMA(1, 1, At, B1); PG8_BAR; PG8_SCHED;
        }
        if constexpr (ALIGN_EPI) { if (wr == 0) PG8_BAR; }
        E(acc, cur, wid, wr, wc, fr, fq);
        if (!has_next) break;
#pragma unroll
        for (int a = 0; a < 2; ++a)
#pragma unroll
            for (int b = 0; b < 2; ++b)
#pragma unroll
                for (int m = 0; m < 4; ++m)
#pragma unroll
                    for (int n = 0; n < 2; ++n) acc[a][b][m][n] = (f32x4){0.f, 0.f, 0.f, 0.f};
        cur = nxt; cA = nA; cB = nB; ++ui;
        if constexpr (ALIGN_EPI) { if (wr == 1) PG8_BAR; }
    }
    PG8_WAIT_V(0);
    if constexpr (!ALIGN_EPI) { if (wr == 0) PG8_BAR; }
    PG8_BAR;
#undef PG8_SA
#undef PG8_SB
#undef PG8_STAGE
#undef PG8_LDA
#undef PG8_LDB
#undef PG8_MMA
#undef PG8_WAIT_V
#undef PG8_WAIT_L
#undef PG8_BAR
#undef PG8_SCHED
}

typedef const f32x4 (&AccRef)[2][2][4][2];
__device__ __forceinline__ void load_rs8(const float* ss, int row0, float (&r)[8]) {
    float p[8][4];
#pragma unroll
    for (int i = 0; i < 8; ++i)
#pragma unroll
        for (int q = 0; q < 4; ++q) p[i][q] = ss[(size_t)q * M + row0 + (i >> 2) * HALF + (i & 3) * 16];
    asm volatile("" ::: "memory");
#pragma unroll
    for (int i = 0; i < 8; ++i) r[i] = __builtin_amdgcn_rsqf(((p[i][0] + p[i][1]) + (p[i][2] + p[i][3])) * (1.0f / D) + EPS);
}
template <bool RS> struct EpiSwiGLU {
    bf16_t* act; const float* ss;
    __device__ __forceinline__ void operator()(AccRef acc, const Unit& u, int wid, int wr, int wc, int fr, int fq) const {
        const int row0 = u.pm * BM + wr * 64 + fr, col0 = u.pn * HALF + wc * 32 + 8 * fq;
        float rs[8];
        if constexpr (RS) load_rs8(ss, row0, rs); else {
#pragma unroll
            for (int i = 0; i < 8; ++i) rs[i] = 1.0f; }
#pragma unroll
        for (int ai = 0; ai < 2; ++ai)
#pragma unroll
            for (int m = 0; m < 4; ++m) {
                const int row = row0 + ai * HALF + m * 16; const float r = rs[ai * 4 + m]; float o[8];
#pragma unroll
                for (int n = 0; n < 2; ++n)
#pragma unroll
                    for (int j = 0; j < 4; ++j) { const float gt = acc[ai][0][m][n][j] * r, up = acc[ai][1][m][n][j] * r; o[n * 4 + j] = gt * fast_sigmoid(gt) * up; }
                u32x4 w; w.x = cvt_pk_bf16(o[0], o[1]); w.y = cvt_pk_bf16(o[2], o[3]); w.z = cvt_pk_bf16(o[4], o[5]); w.w = cvt_pk_bf16(o[6], o[7]);
                *(u32x4*)(act + (size_t)row * DFF + col0) = w;
            }
    }
};
template <bool BASE_BF16, bool OUT_BF16> struct EpiResid {
    const void* base; void* out; float* ss; float alpha; LAS float* P;
    __device__ __forceinline__ void operator()(AccRef acc, const Unit& u, int wid, int wr, int wc, int fr, int fq) const {
        const int rl0 = wr * 64 + fr, col0 = u.pn * BM + wc * 32 + 8 * fq;
        u32x4 bb[2][4][2];
        if constexpr (BASE_BF16) {
#pragma unroll
            for (int ai = 0; ai < 2; ++ai)
#pragma unroll
                for (int m = 0; m < 4; ++m)
#pragma unroll
                    for (int bj = 0; bj < 2; ++bj) bb[ai][m][bj] = *(const u32x4*)((const bf16_t*)base + (size_t)(u.pm * BM + rl0 + ai * HALF + m * 16) * D + col0 + bj * HALF);
            asm volatile("" ::: "memory");
        }
#pragma unroll
        for (int ai = 0; ai < 2; ++ai) {
            f32x4 b[4][2][2];
            if constexpr (!BASE_BF16) {
#pragma unroll
                for (int m = 0; m < 4; ++m)
#pragma unroll
                    for (int bj = 0; bj < 2; ++bj) { const size_t off = (size_t)(u.pm * BM + rl0 + ai * HALF + m * 16) * D + col0 + bj * HALF;
                        b[m][bj][0] = *(const f32x4*)((const float*)base + off); b[m][bj][1] = *(const f32x4*)((const float*)base + off + 4); }
                asm volatile("" ::: "memory");
            } else {
#pragma unroll
                for (int m = 0; m < 4; ++m)
#pragma unroll
                    for (int bj = 0; bj < 2; ++bj) { const u32x4 q = bb[ai][m][bj];
                        b[m][bj][0] = (f32x4){bf_lo(q.x), bf_hi(q.x), bf_lo(q.y), bf_hi(q.y)}; b[m][bj][1] = (f32x4){bf_lo(q.z), bf_hi(q.z), bf_lo(q.w), bf_hi(q.w)}; }
            }
#pragma unroll
            for (int m = 0; m < 4; ++m) {
                const int rl = rl0 + ai * HALF + m * 16; const size_t off = (size_t)(u.pm * BM + rl) * D + col0; float s = 0.f;
#pragma unroll
                for (int bj = 0; bj < 2; ++bj) {
                    const f32x4 v0 = b[m][bj][0] + acc[ai][bj][m][0] * alpha, v1 = b[m][bj][1] + acc[ai][bj][m][1] * alpha;
                    if constexpr (OUT_BF16) { u32x4 w; w.x = cvt_pk_bf16(v0[0], v0[1]); w.y = cvt_pk_bf16(v0[2], v0[3]); w.z = cvt_pk_bf16(v1[0], v1[1]); w.w = cvt_pk_bf16(v1[2], v1[3]); *(u32x4*)((bf16_t*)out + off + bj * HALF) = w; }
                    else { *(f32x4*)((float*)out + off + bj * HALF) = v0; *(f32x4*)((float*)out + off + bj * HALF + 4) = v1; }
                    s += (v0[0] * v0[0] + v0[1] * v0[1]) + (v0[2] * v0[2] + v0[3] * v0[3]) + (v1[0] * v1[0] + v1[1] * v1[1]) + (v1[2] * v1[2] + v1[3] * v1[3]);
                }
                if (ss) { s += __shfl_xor(s, 16); s += __shfl_xor(s, 32); if (fq == 0) P[rl * 4 + wc] = s; }
            }
        }
        if (ss) {
            asm volatile("s_waitcnt lgkmcnt(0)" ::: "memory"); __builtin_amdgcn_s_barrier(); asm volatile("" ::: "memory");
            const int t = threadIdx.x;
            if (t < 256) { const f32x4 p = *(const LAS f32x4*)(P + t * 4); ss[(size_t)u.pn * M + u.pm * BM + t] = (p[0] + p[1]) + (p[2] + p[3]); }
        }
    }
};
struct EpiWin {
    bf16_t* z; float* zif; const float* bias; const float* ss;
    __device__ __forceinline__ void operator()(AccRef acc, const Unit& u, int wid, int wr, int wc, int fr, int fq) const {
        const int row0 = u.pm * BM + wr * 64 + fr, col0 = u.pn * BM + wc * 32 + 8 * fq;
        float rs[8]; load_rs8(ss, row0, rs);
        if (u.pn == 18) {
            if (wc == 0 && fq == 0) {
                const f32x4 bi = *(const f32x4*)(bias + ZW), bf = *(const f32x4*)(bias + ZW + 4);
#pragma unroll
                for (int ai = 0; ai < 2; ++ai)
#pragma unroll
                    for (int m = 0; m < 4; ++m) {
                        const int row = row0 + ai * HALF + m * 16; const float r = rs[ai * 4 + m];
                        const f32x4 vi = acc[ai][0][m][0] * r + bi, vf = acc[ai][0][m][1] * r + bf; f32x4 lf;
#pragma unroll
                        for (int j = 0; j < 4; ++j) { const float x = vf[j]; lf[j] = fminf(x, 0.f) - __logf(1.0f + __expf(-fabsf(x))); }
                        *(f32x4*)(zif + (size_t)row * 8) = vi; *(f32x4*)(zif + (size_t)row * 8 + 4) = lf;
                    }
            }
            return;
        }
        const bool sg = (u.pn == 6) | (u.pn == 7) | (u.pn >= 10);
        f32x4 bv[2][2];
#pragma unroll
        for (int bj = 0; bj < 2; ++bj)
#pragma unroll
            for (int n = 0; n < 2; ++n) bv[bj][n] = *(const f32x4*)(bias + col0 + bj * HALF + 4 * n);
        asm volatile("" ::: "memory");
#pragma unroll
        for (int ai = 0; ai < 2; ++ai)
#pragma unroll
            for (int m = 0; m < 4; ++m) {
                const int row = row0 + ai * HALF + m * 16; const float r = rs[ai * 4 + m];
#pragma unroll
                for (int bj = 0; bj < 2; ++bj) {
                    f32x4 v0 = acc[ai][bj][m][0] * r + bv[bj][0], v1 = acc[ai][bj][m][1] * r + bv[bj][1];
                    if (sg) {
#pragma unroll
                        for (int j = 0; j < 4; ++j) { v0[j] = fast_sigmoid(v0[j]); v1[j] = fast_sigmoid(v1[j]); } }
                    u32x4 w; w.x = cvt_pk_bf16(v0[0], v0[1]); w.y = cvt_pk_bf16(v0[2], v0[3]); w.z = cvt_pk_bf16(v1[0], v1[1]); w.w = cvt_pk_bf16(v1[2], v1[3]);
                    *(u32x4*)(z + (size_t)row * ZW + col0 + bj * HALF) = w;
                }
            }
    }
};
template <bool ADD> struct EpiMerge {
    bf16_t* mg; const bf16_t* z; int gcol0;
    __device__ __forceinline__ void operator()(AccRef acc, const Unit& u, int wid, int wr, int wc, int fr, int fq) const {
        const int row0 = u.pm * BM + wr * 64 + fr, col0 = u.pn * BM + wc * 32 + 8 * fq;
#pragma unroll
        for (int ai = 0; ai < 2; ++ai) {
            u32x4 gt[4][2], pv[4][2];
#pragma unroll
            for (int m = 0; m < 4; ++m)
#pragma unroll
                for (int bj = 0; bj < 2; ++bj) { const int row = row0 + ai * HALF + m * 16;
                    gt[m][bj] = *(const u32x4*)(z + (size_t)row * ZW + gcol0 + col0 + bj * HALF);
                    if (ADD) pv[m][bj] = *(const u32x4*)(mg + (size_t)row * D + col0 + bj * HALF); }
            asm volatile("" ::: "memory");
#pragma unroll
            for (int m = 0; m < 4; ++m)
#pragma unroll
                for (int bj = 0; bj < 2; ++bj) { const int row = row0 + ai * HALF + m * 16; const u32x4 g = gt[m][bj];
                    f32x4 v0 = acc[ai][bj][m][0], v1 = acc[ai][bj][m][1];
                    v0[0] *= bf_lo(g.x); v0[1] *= bf_hi(g.x); v0[2] *= bf_lo(g.y); v0[3] *= bf_hi(g.y);
                    v1[0] *= bf_lo(g.z); v1[1] *= bf_hi(g.z); v1[2] *= bf_lo(g.w); v1[3] *= bf_hi(g.w);
                    if (ADD) { const u32x4 q = pv[m][bj];
                        v0[0] += bf_lo(q.x); v0[1] += bf_hi(q.x); v0[2] += bf_lo(q.y); v0[3] += bf_hi(q.y);
                        v1[0] += bf_lo(q.z); v1[1] += bf_hi(q.z); v1[2] += bf_lo(q.w); v1[3] += bf_hi(q.w); }
                    u32x4 w; w.x = cvt_pk_bf16(v0[0], v0[1]); w.y = cvt_pk_bf16(v0[2], v0[3]); w.z = cvt_pk_bf16(v1[0], v1[1]); w.w = cvt_pk_bf16(v1[2], v1[3]);
                    *(u32x4*)(mg + (size_t)row * D + col0 + bj * HALF) = w; }
        }
    }
};
}

struct Args {
    const float* x; const float* n1g; const float* wgu1; const float* wdn1; const float* mng; const float* win; const float* bin; const float* convw;
    const float* hng; const float* pa; const float* wpool; const float* pscale; const float* pb; const float* wout; const float* n2g; const float* wgu2; const float* wdn2; const float* fng;
    float* out; unsigned char* ws; int ph_lo, ph_hi;
};

__device__ __forceinline__ float wave_sum(float v) {
#pragma unroll
    for (int o = 1; o < 64; o <<= 1) v += __shfl_xor(v, o);
    return v;
}
__device__ __forceinline__ float wave_max(float v) {
#pragma unroll
    for (int o = 1; o < 64; o <<= 1) v = fmaxf(v, __shfl_xor(v, o));
    return v;
}
__device__ __forceinline__ void transpose_item(const float* W, int N, int nvalid, const float* gain, bf16_t* WT, int ldt, int k0, int n0, int drow0, LAS float* scr, int lane) {
    const int n = n0 + (lane & 31); const bool ok = n < nvalid; float v[32];
#pragma unroll
    for (int i = 0; i < 32; ++i) { v[i] = 0.f; if (ok) v[i] = W[(size_t)(k0 + 2 * i + (lane >> 5)) * N + n]; }
    const int c = lane & 7;
    f32x4 g0 = {1.f, 1.f, 1.f, 1.f}, g1 = g0; if (gain) { g0 = *(const f32x4*)(gain + k0 + 8 * c); g1 = *(const f32x4*)(gain + k0 + 8 * c + 4); }
#pragma unroll
    for (int i = 0; i < 32; ++i) scr[(2 * i + (lane >> 5)) * 33 + (lane & 31)] = v[i];
    asm volatile("s_waitcnt lgkmcnt(0)" ::: "memory");
#pragma unroll
    for (int j = 0; j < 4; ++j) { const int nn = (lane >> 3) + 8 * j; const LAS float* sp = scr + (8 * c) * 33 + nn;
        u32x4 o; o.x = cvt_pk_bf16(sp[0 * 33] * g0[0], sp[1 * 33] * g0[1]); o.y = cvt_pk_bf16(sp[2 * 33] * g0[2], sp[3 * 33] * g0[3]);
        o.z = cvt_pk_bf16(sp[4 * 33] * g1[0], sp[5 * 33] * g1[1]); o.w = cvt_pk_bf16(sp[6 * 33] * g1[2], sp[7 * 33] * g1[3]);
        *(u32x4*)(WT + (size_t)(drow0 + nn) * ldt + k0 + 8 * c) = o; }
    asm volatile("s_waitcnt lgkmcnt(0)" ::: "memory");
}
__device__ __forceinline__ int gu_row(int n0) {
    const int isup = n0 >= DFF, nn = isup ? n0 - DFF : n0; return 256 * (nn >> 7) + (isup ? 128 : 0) + (nn & 127);
}

__device__ __forceinline__ void p0_prologue(const Args& a, LAS unsigned char* lds, int gw, int NGW, int lane, int wave) {
    unsigned char* ws = a.ws;
    LAS float* scr = (LAS float*)(lds + wave * 16384);
    constexpr int I_GU = (D / 64) * (NGU / 32), I_DN = (DFF / 64) * (D / 32), I_IN = (D / 64) * (NIN / 32), I_PA = (512 / 64) * (D / 32), I_WO = (D / 64) * (D / 32);
    constexpr int NITEMS = 2 * I_GU + 2 * I_DN + I_IN + I_PA + I_WO;
    for (int it = gw; it < NITEMS; it += NGW) {
        int r = it;
        if (r < I_GU) { const int nb = r % (NGU / 32), kb = r / (NGU / 32); transpose_item(a.wgu1, NGU, NGU, a.n1g, (bf16_t*)(ws + WS_WGU1), D, kb * 64, nb * 32, gu_row(nb * 32) - 0, scr, lane); continue; } r -= I_GU;
        if (r < I_GU) { const int nb = r % (NGU / 32), kb = r / (NGU / 32); transpose_item(a.wgu2, NGU, NGU, a.n2g, (bf16_t*)(ws + WS_WGU2), D, kb * 64, nb * 32, gu_row(nb * 32) - 0, scr, lane); continue; } r -= I_GU;
        if (r < I_DN) { const int nb = r % (D / 32), kb = r / (D / 32); transpose_item(a.wdn1, D, D, nullptr, (bf16_t*)(ws + WS_WDN1), DFF, kb * 64, nb * 32, nb * 32, scr, lane); continue; } r -= I_DN;
        if (r < I_DN) { const int nb = r % (D / 32), kb = r / (D / 32); transpose_item(a.wdn2, D, D, nullptr, (bf16_t*)(ws + WS_WDN2), DFF, kb * 64, nb * 32, nb * 32, scr, lane); continue; } r -= I_DN;
        if (r < I_IN) { const int nb = r % (NIN / 32), kb = r / (NIN / 32); transpose_item(a.win, DIN, DIN, a.mng, (bf16_t*)(ws + WS_WIN), D, kb * 64, nb * 32, nb * 32, scr, lane); continue; } r -= I_IN;
        if (r < I_PA) { const int nb = r % (D / 32), kb = r / (D / 32); transpose_item(a.pa, D, D, nullptr, (bf16_t*)(ws + WS_WAB), D, kb * 64, nb * 32, nb * 32, scr, lane); continue; } r -= I_PA;
        { const int nb = r % (D / 32), kb = r / (D / 32); transpose_item(a.wout, D, D, nullptr, (bf16_t*)(ws + WS_WOUT), D, kb * 64, nb * 32, nb * 32, scr, lane); }
    }
    {
        bf16_t* wab = (bf16_t*)(ws + WS_WAB);
        const int o = gw * 64 + lane;
        if (o < 128 * D) {
            const int n = o & (D - 1), c = o >> 10; float acc4[4] = {0.f, 0.f, 0.f, 0.f};
            for (int d0 = 0; d0 < 128; d0 += 8) {
#pragma unroll
                for (int g = 0; g < 4; ++g) {
                    const f32x4 w0 = *(const f32x4*)(a.wpool + (size_t)(g * 128 + c) * 128 + d0), w1 = *(const f32x4*)(a.wpool + (size_t)(g * 128 + c) * 128 + d0 + 4);
                    const f32x4 p0 = *(const f32x4*)(a.pscale + g * 128 + d0), p1 = *(const f32x4*)(a.pscale + g * 128 + d0 + 4);
                    const float* pb = a.pb + (size_t)(g * 128 + d0) * D + n; float bv[8];
#pragma unroll
                    for (int e = 0; e < 8; ++e) bv[e] = pb[(size_t)e * D];
                    acc4[g] += (w0[0] * p0[0] * bv[0] + w0[1] * p0[1] * bv[1]) + (w0[2] * p0[2] * bv[2] + w0[3] * p0[3] * bv[3])
                             + (w1[0] * p1[0] * bv[4] + w1[1] * p1[1] * bv[5]) + (w1[2] * p1[2] * bv[6] + w1[3] * p1[3] * bv[7]);
                }
            }
#pragma unroll
            for (int g = 0; g < 4; ++g) wab[(size_t)n * D + 512 + g * 128 + c] = f2bf_s(acc4[g]);
        }
    }
    {
        bf16_t* hb = (bf16_t*)(ws + WS_H); float* ss = (float*)(ws + WS_SS);
        for (int m0 = gw * 4; m0 < M; m0 += NGW * 4) {
            f32x4 v[4][4]; float sq[4];
#pragma unroll
            for (int q = 0; q < 4; ++q) { const f32x4* xr = (const f32x4*)(a.x + (size_t)(m0 + q) * D) + lane;
#pragma unroll
                for (int j = 0; j < 4; ++j) v[q][j] = xr[64 * j]; }
#pragma unroll
            for (int q = 0; q < 4; ++q) { float t = 0.f;
#pragma unroll
                for (int j = 0; j < 4; ++j) t += (v[q][j][0] * v[q][j][0] + v[q][j][1] * v[q][j][1]) + (v[q][j][2] * v[q][j][2] + v[q][j][3] * v[q][j][3]);
                sq[q] = wave_sum(t); }
#pragma unroll
            for (int q = 0; q < 4; ++q) { const float r = __builtin_amdgcn_rsqf(sq[q] * (1.0f / D) + EPS);
                u32x2* o8 = (u32x2*)(hb + (size_t)(m0 + q) * D) + lane;
#pragma unroll
                for (int j = 0; j < 4; ++j) { u32x2 w; w.x = cvt_pk_bf16(v[q][j][0] * r, v[q][j][1] * r); w.y = cvt_pk_bf16(v[q][j][2] * r, v[q][j][3] * r); o8[64 * j] = w; } }
            if (lane < 16) { const int q = lane >> 2, pp = lane & 3; ss[(size_t)pp * M + m0 + q] = pp == 0 ? (q == 0 ? sq[0] : q == 1 ? sq[1] : q == 2 ? sq[2] : sq[3]) : 0.f; }
        }
    }
}

constexpr int QP = 136, TP = 72;
__device__ __forceinline__ bf16x8 ldfrag(const LAS bf16_t* base, int pitch, int row, int kofs) { return *(const LAS bf16x8*)(base + row * pitch + kofs); }
__device__ __forceinline__ float silu_f(float x) { return x * fast_sigmoid(x); }
__device__ __forceinline__ void unpack8(const u32x4 v, float (&f)[8]) { f[0] = bf_lo(v.x); f[1] = bf_hi(v.x); f[2] = bf_lo(v.y); f[3] = bf_hi(v.y); f[4] = bf_lo(v.z); f[5] = bf_hi(v.z); f[6] = bf_lo(v.w); f[7] = bf_hi(v.w); }
__device__ __forceinline__ void load_taps(const bf16_t* z, int r0, int s, int seq0, int col, u32x4 (&t)[4]) {
#pragma unroll
    for (int j = 0; j < 4; ++j) { const int tt = s - 3 + j; t[j] = (u32x4){0u, 0u, 0u, 0u}; if (seq0 + tt >= 0) t[j] = *(const u32x4*)(z + (size_t)(r0 + tt) * ZW + col); }
}
__device__ __forceinline__ void conv_taps(const u32x4 (&t)[4], const LAS float* cw, int col, float (&o)[8]) {
#pragma unroll
    for (int e = 0; e < 8; ++e) o[e] = 0.f;
#pragma unroll
    for (int j = 0; j < 4; ++j) { float f[8]; unpack8(t[j], f);
        const f32x4 w0 = *(const LAS f32x4*)(cw + j * 1024 + col), w1 = *(const LAS f32x4*)(cw + j * 1024 + col + 4);
        o[0] += w0[0] * f[0]; o[1] += w0[1] * f[1]; o[2] += w0[2] * f[2]; o[3] += w0[3] * f[3];
        o[4] += w1[0] * f[4]; o[5] += w1[1] * f[5]; o[6] += w1[2] * f[6]; o[7] += w1[3] * f[7]; }
#pragma unroll
    for (int e = 0; e < 8; ++e) o[e] = silu_f(o[e]);
}
__device__ __forceinline__ bf16_t f2bf(float x) { return (bf16_t)(cvt_pk_bf16(x, 0.f) & 0xffffu); }

struct P4Regs { u32x4 kt[2][4]; u32x4 vv[2]; u32x4 uu[3]; float lf, ig; };
constexpr int P4_KT = 0, P4_VT = 18432, P4_US = 39168, P4_BUF = 60928, P4_CW = 2 * P4_BUF;
__device__ __forceinline__ void p4_prefetch(const Args& a, int u, P4Regs& R) {
    const bf16_t* z = (const bf16_t*)(a.ws + WS_Z); const float* zif = (const float*)(a.ws + WS_ZIF);
    const int tid = threadIdx.x, lane = tid & 63, wave = tid >> 6;
    const int h = u & 3, c = (u >> 2) & (NCH - 1), b = u >> 9, r0 = b * SEQ + c * CH, seq0 = c * CH;
    R.lf = zif[(size_t)(r0 + lane) * 8 + 4 + h]; R.ig = zif[(size_t)(r0 + lane) * 8 + h];
#pragma unroll
    for (int it = 0; it < 2; ++it) load_taps(z, r0, lane, seq0, ZC_K + h * DH + (wave + 8 * it) * 8, R.kt[it]);
#pragma unroll
    for (int it = 0; it < 2; ++it) R.vv[it] = *(const u32x4*)(z + (size_t)(r0 + lane) * ZW + ZC_V + h * DH + (wave + 8 * it) * 8);
#pragma unroll
    for (int it = 0; it < 3; ++it) { const int idx = tid + 512 * it, row = idx >> 4, cg = idx & 15; R.uu[it] = (u32x4){0u, 0u, 0u, 0u};
        if (idx < 79 * 16 && seq0 - 15 + row >= 0) R.uu[it] = *(const u32x4*)(z + (size_t)(r0 - 15 + row) * ZW + ZC_U + h * 128 + cg * 8); }
}
__device__ __forceinline__ void p4_phase(const Args& a, LAS unsigned char* lds, int vcu) {
    unsigned char* ws = a.ws;
    const int tid = threadIdx.x, lane = tid & 63, wave = tid >> 6, fr = lane & 15, fq = lane >> 4;
    LAS float* cw = (LAS float*)(lds + P4_CW);
    {
#pragma unroll
        for (int it = 0; it < 2; ++it) *(LAS f32x4*)(cw + (tid + 512 * it) * 4) = *(const f32x4*)(a.convw + (tid + 512 * it) * 4);
        for (int i = tid; i < 2 * 16 * TP / 2; i += 512) { const int bsel = i / (16 * TP / 2), w = i % (16 * TP / 2); ((LAS unsigned*)(lds + bsel * P4_BUF + P4_VT + 128 * TP * 2))[w] = 0u; }
    }
    __syncthreads();
    const int u0 = vcu * (NUNIT / 256);
    P4Regs R; p4_prefetch(a, u0, R);
    for (int i = 0; i < NUNIT / 256; ++i) {
        const int u = u0 + i, h = u & 3, c = (u >> 2) & (NCH - 1), b = u >> 9, r0 = b * SEQ + c * CH, seq0 = c * CH;
        LAS unsigned char* buf = lds + (i & 1) * P4_BUF;
        LAS bf16_t* KT = (LAS bf16_t*)(buf + P4_KT); LAS bf16_t* VT = (LAS bf16_t*)(buf + P4_VT); LAS bf16_t* Us = (LAS bf16_t*)(buf + P4_US);
        bf16_t* a2 = (bf16_t*)(ws + WS_A2);
        float bc = R.lf;
#pragma unroll
        for (int o = 1; o < 64; o <<= 1) { const float t = __shfl_up(bc, o); if (lane >= o) bc += t; }
        const float Bt = __shfl(bc, 63), g = Bt - bc + R.ig, ml = wave_max(g), w = __expf(g - ml);
        if (tid == 0) { ((float*)(ws + WS_UB))[u] = Bt; ((float*)(ws + WS_UM))[u] = ml; }
#pragma unroll
        for (int it = 0; it < 2; ++it) { const int dg = wave + 8 * it; float o[8];
            conv_taps(R.kt[it], cw, ZC_K + h * DH + dg * 8, o);
#pragma unroll
            for (int e = 0; e < 8; ++e) o[e] *= 0.08838834764831845f;
            u32x4 kw; kw.x = cvt_pk_bf16(o[0], o[1]); kw.y = cvt_pk_bf16(o[2], o[3]); kw.z = cvt_pk_bf16(o[4], o[5]); kw.w = cvt_pk_bf16(o[6], o[7]);
            *(u32x4*)(a2 + (size_t)(r0 + lane) * D + h * DH + dg * 8) = kw;
            const unsigned kk[4] = {kw.x, kw.y, kw.z, kw.w};
#pragma unroll
            for (int e = 0; e < 4; ++e) { KT[(dg * 8 + 2 * e) * TP + lane] = (bf16_t)(kk[e] & 0xffffu); KT[(dg * 8 + 2 * e + 1) * TP + lane] = (bf16_t)(kk[e] >> 16); } }
#pragma unroll
        for (int it = 0; it < 2; ++it) { const int vg = wave + 8 * it; float f[8]; unpack8(R.vv[it], f);
#pragma unroll
            for (int e = 0; e < 8; ++e) VT[(vg * 8 + e) * TP + lane] = f2bf(f[e] * w); }
        if (wave == 0) VT[128 * TP + lane] = f2bf(w);
#pragma unroll
        for (int it = 0; it < 3; ++it) { const int idx = tid + 512 * it, row = idx >> 4, cg = idx & 15; if (idx < 79 * 16) *(LAS u32x4*)(Us + row * QP + cg * 8) = R.uu[it]; }
        __syncthreads();
        if (i + 1 < NUNIT / 256) p4_prefetch(a, u + 1, R);
        {
            bf16_t* dc = (bf16_t*)(ws + WS_CST) + (size_t)u * DH * DH;
            const int v0 = wave * 16;
            const bf16x8 bv0 = ldfrag(VT, TP, v0 + fr, 8 * fq), bv1 = ldfrag(VT, TP, v0 + fr, 32 + 8 * fq);
            bf16x8 nv0 = bv0, nv1 = bv1; if (wave == 0) { nv0 = ldfrag(VT, TP, 128 + fr, 8 * fq); nv1 = ldfrag(VT, TP, 128 + fr, 32 + 8 * fq); }
#pragma unroll
            for (int dt = 0; dt < 8; ++dt) {
                const bf16x8 a0 = ldfrag(KT, TP, dt * 16 + fr, 8 * fq), a1 = ldfrag(KT, TP, dt * 16 + fr, 32 + 8 * fq);
                f32x4 acc = {0.f, 0.f, 0.f, 0.f};
                acc = __builtin_amdgcn_mfma_f32_16x16x32_bf16(a0, bv0, acc, 0, 0, 0);
                acc = __builtin_amdgcn_mfma_f32_16x16x32_bf16(a1, bv1, acc, 0, 0, 0);
                u32x2 wv; wv.x = cvt_pk_bf16(acc[0], acc[1]); wv.y = cvt_pk_bf16(acc[2], acc[3]);
                *(u32x2*)(dc + (size_t)(v0 + fr) * DH + dt * 16 + 4 * fq) = wv;
                if (wave == 0) { f32x4 an = {0.f, 0.f, 0.f, 0.f};
                    an = __builtin_amdgcn_mfma_f32_16x16x32_bf16(a0, nv0, an, 0, 0, 0);
                    an = __builtin_amdgcn_mfma_f32_16x16x32_bf16(a1, nv1, an, 0, 0, 0);
                    if (fr == 0) *(f32x4*)((float*)(ws + WS_NST) + (size_t)u * DH + dt * 16 + 4 * fq) = an; }
            }
        }
        {
            const int win = 2 << h;
#pragma unroll
            for (int it = 0; it < 2; ++it) { const int idx = tid + 512 * it, s = idx >> 4, cg = idx & 15, pos = seq0 + s; const int cnt = pos + 1 < win ? pos + 1 : win;
                float sum[8], cur[8]; unpack8(*(const LAS u32x4*)(Us + (s + 15) * QP + cg * 8), cur);
#pragma unroll
                for (int e = 0; e < 8; ++e) sum[e] = cur[e];
                for (int j = 1; j < win; ++j) { float f[8]; unpack8(*(const LAS u32x4*)(Us + (s + 15 - j) * QP + cg * 8), f);
#pragma unroll
                    for (int e = 0; e < 8; ++e) sum[e] += f[e]; }
                const float inv = 1.0f / (float)cnt;
                u32x4 wv; wv.x = cvt_pk_bf16(sum[0] * inv - cur[0], sum[1] * inv - cur[1]); wv.y = cvt_pk_bf16(sum[2] * inv - cur[2], sum[3] * inv - cur[3]);
                wv.z = cvt_pk_bf16(sum[4] * inv - cur[4], sum[5] * inv - cur[5]); wv.w = cvt_pk_bf16(sum[6] * inv - cur[6], sum[7] * inv - cur[7]);
                *(u32x4*)(a2 + (size_t)(r0 + s) * D + 512 + h * 128 + cg * 8) = wv; }
        }
    }
    __syncthreads();
}

struct P5Batch { u32x2 dv[8]; float dn[8], Bt[8], ml[8]; };
__device__ __forceinline__ void p5_load(const Args& a, int b, int h, int cb, int eoff, bool do_n, P5Batch& B) {
    const bf16_t* dcs = (const bf16_t*)(a.ws + WS_CST); const float* dns = (const float*)(a.ws + WS_NST);
    const float* uB = (const float*)(a.ws + WS_UB); const float* uM = (const float*)(a.ws + WS_UM);
#pragma unroll
    for (int i = 0; i < 8; ++i) { const int u = ((b * NCH + cb + i) << 2) + h;
        B.dv[i] = *(const u32x2*)(dcs + (size_t)u * DH * DH + eoff); B.dn[i] = do_n ? dns[(size_t)u * DH + threadIdx.x] : 0.f; B.Bt[i] = uB[u]; B.ml[i] = uM[u]; }
}
struct P5State { float C0, C1, C2, C3, nn, mst; };
__device__ __forceinline__ void p5_step(const Args& a, int b, int h, int cb, int eoff, bool do_n, bool do_m, const P5Batch& B, P5State& S) {
    bf16_t* cst = (bf16_t*)(a.ws + WS_CST); float* nst = (float*)(a.ws + WS_NST2); float* uMS = (float*)(a.ws + WS_UMS);
#pragma unroll
    for (int i = 0; i < 8; ++i) { const int u = ((b * NCH + cb + i) << 2) + h;
        const float mn = fmaxf(B.Bt[i] + S.mst, B.ml[i]), dec = __expf(B.Bt[i] + S.mst - mn), sc = __expf(B.ml[i] - mn);
        S.C0 = dec * S.C0 + sc * bf_lo(B.dv[i].x); S.C1 = dec * S.C1 + sc * bf_hi(B.dv[i].x); S.C2 = dec * S.C2 + sc * bf_lo(B.dv[i].y); S.C3 = dec * S.C3 + sc * bf_hi(B.dv[i].y);
        S.nn = dec * S.nn + sc * B.dn[i]; S.mst = mn;
        u32x2 w; w.x = cvt_pk_bf16(S.C0, S.C1); w.y = cvt_pk_bf16(S.C2, S.C3);
        *(u32x2*)(cst + (size_t)u * DH * DH + eoff) = w;
        if (do_n) nst[(size_t)u * DH + threadIdx.x] = S.nn;
        if (do_m) uMS[u] = mn; }
}
__device__ __forceinline__ void p5_scan(const Args& a, int wg) {
    const int tid = threadIdx.x, stream = wg >> 3, slice = wg & 7, b = stream >> 2, h = stream & 3;
    const int eoff = (slice * 16 + (tid >> 5)) * DH + (tid & 31) * 4;
    const bool do_n = (slice == 0) && (tid < 128), do_m = (slice == 0) && (tid == 0);
    P5State S{0.f, 0.f, 0.f, 0.f, 0.f, 0.f}; P5Batch A, Bb;
    p5_load(a, b, h, 0, eoff, do_n, A);
    for (int cb = 0; cb < NCH; cb += 16) {
        p5_load(a, b, h, cb + 8, eoff, do_n, Bb);
        p5_step(a, b, h, cb, eoff, do_n, do_m, A, S);
        if (cb + 16 < NCH) p5_load(a, b, h, cb + 16, eoff, do_n, A);
        p5_step(a, b, h, cb + 8, eoff, do_n, do_m, Bb, S);
    }
}

struct P6Regs { u32x4 qt[2][4]; u32x4 kc[2]; u32x4 vv[2]; u32x4 cc[4]; u32x2 so[4]; f32x4 gn; float nn, lf, ig, mp; };
constexpr int P6_Q = 0, P6_K = 17408, P6_VT = 34816, P6_C = 53248, P6_P = 88064, P6_SM = 97280, P6_CW = 101632;
__device__ __forceinline__ void p6_prefetch(const Args& a, int u, P6Regs& R) {
    const bf16_t* z = (const bf16_t*)(a.ws + WS_Z); const float* zif = (const float*)(a.ws + WS_ZIF); const bf16_t* a2 = (const bf16_t*)(a.ws + WS_A2);
    const int tid = threadIdx.x, lane = tid & 63, wave = tid >> 6, fr = lane & 15, fq = lane >> 4;
    const int h = u & 3, c = (u >> 2) & (NCH - 1), b = u >> 9, r0 = b * SEQ + c * CH, seq0 = c * CH;
    R.lf = 0.f; R.ig = 0.f; R.mp = 0.f;
    if (wave == 0) { R.lf = zif[(size_t)(r0 + lane) * 8 + 4 + h]; R.ig = zif[(size_t)(r0 + lane) * 8 + h]; if (c > 0) R.mp = ((const float*)(a.ws + WS_UMS))[u - NH]; }
#pragma unroll
    for (int it = 0; it < 2; ++it) { const int idx = tid + 512 * it, s = idx >> 4, dg = idx & 15;
        load_taps(z, r0, s, seq0, ZC_Q + h * DH + dg * 8, R.qt[it]);
        R.kc[it] = *(const u32x4*)(a2 + (size_t)(r0 + s) * D + h * DH + dg * 8); }
#pragma unroll
    for (int it = 0; it < 2; ++it) R.vv[it] = *(const u32x4*)(z + (size_t)(r0 + lane) * ZW + ZC_V + h * DH + (wave + 8 * it) * 8);
    const bf16_t* cp = (const bf16_t*)(a.ws + WS_CST) + (size_t)(u - NH) * DH * DH;
#pragma unroll
    for (int it = 0; it < 4; ++it) { const int idx = tid + 512 * it, v = idx >> 4, dg = idx & 15; R.cc[it] = (u32x4){0u, 0u, 0u, 0u}; if (c > 0) R.cc[it] = *(const u32x4*)(cp + v * DH + dg * 8); }
    R.nn = 0.f; if (c > 0 && tid < 128) R.nn = ((const float*)(a.ws + WS_NST2))[(size_t)(u - NH) * DH + tid];
#pragma unroll
    for (int tt = 0; tt < 4; ++tt) R.so[tt] = *(const u32x2*)(z + (size_t)(r0 + tt * 16 + fr) * ZW + ZC_O + h * DH + wave * 16 + 4 * fq);
    R.gn = *(const f32x4*)(a.hng + h * DH + wave * 16 + 4 * fq);
}
__device__ __forceinline__ void p6_phase(const Args& a, LAS unsigned char* lds, int vcu) {
    unsigned char* ws = a.ws;
    const int tid = threadIdx.x, lane = tid & 63, wave = tid >> 6, fr = lane & 15, fq = lane >> 4;
    LAS bf16_t* Qs = (LAS bf16_t*)(lds + P6_Q); LAS bf16_t* Ks = (LAS bf16_t*)(lds + P6_K); LAS bf16_t* VT = (LAS bf16_t*)(lds + P6_VT);
    LAS bf16_t* Cs = (LAS bf16_t*)(lds + P6_C); LAS bf16_t* Ps = (LAS bf16_t*)(lds + P6_P);
    LAS float* sN = (LAS float*)(lds + P6_SM); LAS float* sWi = sN + 128; LAS float* sRt = sWi + 64; LAS float* sE = sRt + 64; LAS float* sFl = sE + 64;
    LAS float* rsum = sFl + 64; LAS float* nqs = rsum + 128; LAS float* ssqp = nqs + 64;
    LAS float* cw = (LAS float*)(lds + P6_CW);
#pragma unroll
    for (int it = 0; it < 2; ++it) *(LAS f32x4*)(cw + (tid + 512 * it) * 4) = *(const f32x4*)(a.convw + (tid + 512 * it) * 4);
    __syncthreads();
    const int u0 = vcu * (NUNIT / 256);
    P6Regs R; p6_prefetch(a, u0, R);
    for (int i = 0; i < NUNIT / 256; ++i) {
        const int u = u0 + i, h = u & 3, c = (u >> 2) & (NCH - 1), b = u >> 9, r0 = b * SEQ + c * CH;
        bf16_t* a2 = (bf16_t*)(ws + WS_A2);
        if (wave == 0) {
            float bc = R.lf;
#pragma unroll
            for (int o = 1; o < 64; o <<= 1) { const float t = __shfl_up(bc, o); if (lane >= o) bc += t; }
            const float e = R.ig - bc; float cm = e;
#pragma unroll
            for (int o = 1; o < 64; o <<= 1) { const float t = __shfl_up(cm, o); if (lane >= o) cm = fmaxf(cm, t); }
            const float ai = bc + R.mp, mt = fmaxf(ai, bc + cm);
            sWi[lane] = __expf(ai - mt); sRt[lane] = bc - mt; sE[lane] = e; sFl[lane] = __expf(-mt);
        }
#pragma unroll
        for (int it = 0; it < 2; ++it) { const int idx = tid + 512 * it, s = idx >> 4, dg = idx & 15; float o[8];
            conv_taps(R.qt[it], cw, ZC_Q + h * DH + dg * 8, o);
            u32x4 w; w.x = cvt_pk_bf16(o[0], o[1]); w.y = cvt_pk_bf16(o[2], o[3]); w.z = cvt_pk_bf16(o[4], o[5]); w.w = cvt_pk_bf16(o[6], o[7]);
            *(LAS u32x4*)(Qs + s * QP + dg * 8) = w;
            *(LAS u32x4*)(Ks + s * QP + dg * 8) = R.kc[it]; }
#pragma unroll
        for (int it = 0; it < 2; ++it) { const int vg = wave + 8 * it; const unsigned wv[4] = {R.vv[it].x, R.vv[it].y, R.vv[it].z, R.vv[it].w};
#pragma unroll
            for (int e = 0; e < 4; ++e) { VT[(vg * 8 + 2 * e) * TP + lane] = (bf16_t)(wv[e] & 0xffffu); VT[(vg * 8 + 2 * e + 1) * TP + lane] = (bf16_t)(wv[e] >> 16); } }
#pragma unroll
        for (int it = 0; it < 4; ++it) { const int idx = tid + 512 * it, v = idx >> 4, dg = idx & 15; *(LAS u32x4*)(Cs + v * QP + dg * 8) = R.cc[it]; }
        if (tid < 128) sN[tid] = R.nn;
        const u32x2 so0 = R.so[0], so1 = R.so[1], so2 = R.so[2], so3 = R.so[3]; const f32x4 gn = R.gn;
        __syncthreads();
        if (i + 1 < NUNIT / 256) p6_prefetch(a, u + 1, R);
        {
            const int t0 = (wave & 3) * 16, t = t0 + fr;
            bf16x8 qf[4];
#pragma unroll
            for (int kk = 0; kk < 4; ++kk) qf[kk] = ldfrag(Qs, QP, t, 32 * kk + 8 * fq);
            const float rt = sRt[t]; float ps = 0.f;
#pragma unroll
            for (int i2 = 0; i2 < 2; ++i2) { const int s0 = ((wave >> 2) * 2 + i2) * 16;
                f32x4 acc = {0.f, 0.f, 0.f, 0.f};
#pragma unroll
                for (int kk = 0; kk < 4; ++kk) acc = __builtin_amdgcn_mfma_f32_16x16x32_bf16(ldfrag(Ks, QP, s0 + fr, 32 * kk + 8 * fq), qf[kk], acc, 0, 0, 0);
                float p[4];
#pragma unroll
                for (int j = 0; j < 4; ++j) { const int s = s0 + 4 * fq + j; p[j] = s <= t ? acc[j] * __expf(rt + sE[s]) : 0.f; }
                u32x2 w; w.x = cvt_pk_bf16(p[0], p[1]); w.y = cvt_pk_bf16(p[2], p[3]);
                *(LAS u32x2*)(Ps + t * TP + s0 + 4 * fq) = w;
                ps += (bf_lo(w.x) + bf_hi(w.x)) + (bf_lo(w.y) + bf_hi(w.y)); }
            ps += __shfl_xor(ps, 16); ps += __shfl_xor(ps, 32);
            if (fq == 0) rsum[t * 2 + (wave >> 2)] = ps;
            const int t2 = tid >> 3, part = tid & 7; float nq = 0.f;
#pragma unroll
            for (int d = 0; d < 16; ++d) nq += sN[part * 16 + d] * __uint_as_float((unsigned)Qs[t2 * QP + part * 16 + d] << 16);
            nq += __shfl_xor(nq, 1); nq += __shfl_xor(nq, 2); nq += __shfl_xor(nq, 4);
            if (part == 0) nqs[t2] = nq;
        }
        __syncthreads();
        f32x4 hv[4];
        {
            const int v0 = wave * 16;
            bf16x8 cf[4], vf[2];
#pragma unroll
            for (int kk = 0; kk < 4; ++kk) cf[kk] = ldfrag(Cs, QP, v0 + fr, 32 * kk + 8 * fq);
#pragma unroll
            for (int kk = 0; kk < 2; ++kk) vf[kk] = ldfrag(VT, TP, v0 + fr, 32 * kk + 8 * fq);
#pragma unroll
            for (int tt = 0; tt < 4; ++tt) { const int t = tt * 16 + fr;
                f32x4 ai = {0.f, 0.f, 0.f, 0.f}, ap = {0.f, 0.f, 0.f, 0.f};
#pragma unroll
                for (int kk = 0; kk < 4; ++kk) ai = __builtin_amdgcn_mfma_f32_16x16x32_bf16(cf[kk], ldfrag(Qs, QP, t, 32 * kk + 8 * fq), ai, 0, 0, 0);
#pragma unroll
                for (int kk = 0; kk < 2; ++kk) ap = __builtin_amdgcn_mfma_f32_16x16x32_bf16(vf[kk], ldfrag(Ps, TP, t, 32 * kk + 8 * fq), ap, 0, 0, 0);
                const float wi = sWi[t], den = wi * nqs[t] + (rsum[2 * t] + rsum[2 * t + 1]), inv = 1.0f / fmaxf(fabsf(den), sFl[t]);
                hv[tt] = (ai * wi + ap) * inv;
                float q = (hv[tt][0] * hv[tt][0] + hv[tt][1] * hv[tt][1]) + (hv[tt][2] * hv[tt][2] + hv[tt][3] * hv[tt][3]);
                q += __shfl_xor(q, 16); q += __shfl_xor(q, 32);
                if (fq == 0) ssqp[t * 8 + wave] = q; }
        }
        __syncthreads();
        {
            const u32x2 sov[4] = {so0, so1, so2, so3};
#pragma unroll
            for (int tt = 0; tt < 4; ++tt) { const int t = tt * 16 + fr;
                const f32x4 q0 = *(const LAS f32x4*)(ssqp + t * 8), q1 = *(const LAS f32x4*)(ssqp + t * 8 + 4);
                const float rn = __builtin_amdgcn_rsqf(((q0[0] + q0[1]) + (q0[2] + q0[3]) + (q1[0] + q1[1]) + (q1[2] + q1[3])) * (1.0f / DH) + EPS);
                u32x2 w; w.x = cvt_pk_bf16(hv[tt][0] * rn * gn[0] * bf_lo(sov[tt].x), hv[tt][1] * rn * gn[1] * bf_hi(sov[tt].x));
                w.y = cvt_pk_bf16(hv[tt][2] * rn * gn[2] * bf_lo(sov[tt].y), hv[tt][3] * rn * gn[3] * bf_hi(sov[tt].y));
                *(u32x2*)(a2 + (size_t)(r0 + t) * D + h * DH + wave * 16 + 4 * fq) = w; }
        }
    }
    __syncthreads();
}

__device__ __forceinline__ void p_final(const Args& a, int gw, int NGW, int lane) {
    const f32x4* gp = (const f32x4*)a.fng + lane; f32x4 g[4];
#pragma unroll
    for (int j = 0; j < 4; ++j) g[j] = gp[64 * j];
    for (int m = gw; m < M; m += NGW) {
        f32x4* xr = (f32x4*)(a.out + (size_t)m * D) + lane; f32x4 v[4]; float s = 0.f;
#pragma unroll
        for (int j = 0; j < 4; ++j) { v[j] = xr[64 * j]; s += (v[j][0] * v[j][0] + v[j][1] * v[j][1]) + (v[j][2] * v[j][2] + v[j][3] * v[j][3]); }
        const float r = __builtin_amdgcn_rsqf(wave_sum(s) * (1.0f / D) + EPS);
#pragma unroll
        for (int j = 0; j < 4; ++j) xr[64 * j] = v[j] * r * g[j];
    }
}

__global__ void __launch_bounds__(512, 2) fwd_kernel(Args a) {
    extern __shared__ __attribute__((aligned(16))) unsigned char lds_raw[];
    LAS unsigned char* lds = (LAS unsigned char*)lds_raw;
    volatile LAS unsigned* MISC = (volatile LAS unsigned*)(lds + MISC_OFF);
    const int tid = threadIdx.x, lane = tid & 63, wave = __builtin_amdgcn_readfirstlane(tid >> 6);
    const int G = gridDim.x, bx = blockIdx.x;
    const int vcu = (G % 8 == 0) ? (bx % 8) * (G / 8) + bx / 8 : bx;
    const int gw = vcu * 8 + wave, NGW = G * 8;
    unsigned char* ws = a.ws;
    if (tid < 32) MISC[tid] = 0u;
    __syncthreads();
    XcdBarrier bar; bar.bar = (unsigned*)(ws + WS_CTL) + CW_BAR; bar.x = 0; bar.st = nullptr;
    if (MK_N_LAUNCHES == 1) bar = xcd_barrier_post((unsigned*)(ws + WS_CTL) + CW_BAR, MISC + 8);
    const int lo = a.ph_lo, hi = a.ph_hi;
#define IN(k) (lo <= (k) && (k) < hi)
#define SEAM(k) do { if (IN(k) && IN((k) + 1)) xcd_barrier(bar); } while (0)
    bf16_t* const HB = (bf16_t*)(ws + WS_H); bf16_t* const A2 = (bf16_t*)(ws + WS_A2); bf16_t* const MG = (bf16_t*)(ws + WS_CST); bf16_t* const ZB = (bf16_t*)(ws + WS_Z); bf16_t* const ACT = ZB;
    float* const SS = (float*)(ws + WS_SS);
    LAS float* const EP = (LAS float*)(lds + EPI_OFF);

    if (IN(0)) { p0_prologue(a, lds, gw, NGW, lane, wave); }
    SEAM(0);
    if (IN(1)) {
        pg8::Gemm g{HB, (const bf16_t*)(ws + WS_WGU1), M, NGU, D, D, D}; pg8::StaticOrder S; S.init(M, NGU, G, bx);
        pg8::EpiSwiGLU<false> E{ACT, SS}; pg8::gemm_phase<pg8::EpiSwiGLU<false>, true>(lds, g, S, E);
    }
    SEAM(1);
    if (IN(2)) {
        pg8::Gemm g{ACT, (const bf16_t*)(ws + WS_WDN1), M, D, DFF, DFF, DFF}; pg8::StaticOrder S; S.init(M, D, G, bx);
        pg8::EpiResid<false, true> E{a.x, HB, SS, 0.5f, EP}; pg8::gemm_phase<pg8::EpiResid<false, true>, true>(lds, g, S, E);
    }
    SEAM(2);
    if (IN(3)) {
        pg8::Gemm g{HB, (const bf16_t*)(ws + WS_WIN), M, NIN, D, D, D}; pg8::StaticOrder S; S.init(M, NIN, G, bx);
        pg8::EpiWin E{ZB, (float*)(ws + WS_ZIF), a.bin, SS}; pg8::gemm_phase<pg8::EpiWin, true>(lds, g, S, E);
    }
    SEAM(3);
    if (IN(4)) { p4_phase(a, lds, vcu); }
    SEAM(4);
    if (IN(5)) { p5_scan(a, vcu); }
    SEAM(5);
    if (IN(6)) { p6_phase(a, lds, vcu); }
    SEAM(6);
    if (IN(7)) {
        { pg8::Gemm g{A2, (const bf16_t*)(ws + WS_WAB), M, D, 512, D, D}; pg8::StaticOrder S; S.init(M, D, G, bx);
          pg8::EpiMerge<false> E{MG, ZB, ZC_GA}; pg8::gemm_phase<pg8::EpiMerge<false>, true>(lds, g, S, E); }
        { pg8::Gemm g{A2 + 512, (const bf16_t*)(ws + WS_WAB) + 512, M, D, 512, D, D}; pg8::StaticOrder S; S.init(M, D, G, bx);
          pg8::EpiMerge<true> E{MG, ZB, ZC_GB}; pg8::gemm_phase<pg8::EpiMerge<true>, true>(lds, g, S, E); }
    }
    SEAM(7);
    if (IN(8)) {
        pg8::Gemm g{MG, (const bf16_t*)(ws + WS_WOUT), M, D, D, D, D}; pg8::StaticOrder S; S.init(M, D, G, bx);
        pg8::EpiResid<true, true> E{HB, A2, SS, 1.0f, EP}; pg8::gemm_phase<pg8::EpiResid<true, true>, true>(lds, g, S, E);
    }
    SEAM(8);
    if (IN(9)) {
        pg8::Gemm g{A2, (const bf16_t*)(ws + WS_WGU2), M, NGU, D, D, D}; pg8::StaticOrder S; S.init(M, NGU, G, bx);
        pg8::EpiSwiGLU<true> E{ACT, SS}; pg8::gemm_phase<pg8::EpiSwiGLU<true>, true>(lds, g, S, E);
    }
    SEAM(9);
    if (IN(10)) {
        pg8::Gemm g{ACT, (const bf16_t*)(ws + WS_WDN2), M, D, DFF, DFF, DFF}; pg8::StaticOrder S; S.init(M, D, G, bx);
        pg8::EpiResid<true, false> E{A2, a.out, nullptr, 0.5f, EP}; pg8::gemm_phase<pg8::EpiResid<true, false>, true>(lds, g, S, E);
    }
    SEAM(10);
    if (IN(11)) { p_final(a, gw, NGW, lane); }
#undef IN
#undef SEAM
}

extern "C" void kernel_launch(void* const* d_in, const int* in_sizes, int n_in, void* d_out, int out_size, void* d_ws, size_t ws_size, hipStream_t stream) {
    static int grid = 0;
    if (grid == 0) {
        if (n_in != 18 || in_sizes[0] != M * D || out_size != M * D || ws_size < WS_END) { fprintf(stderr, "kernel_launch: unexpected problem (n_in %d, in0 %d, out %d, ws %zu)\n", n_in, n_in > 0 ? in_sizes[0] : -1, out_size, ws_size); grid = -1; return; }
        int dev = 0, cus = 0, per_cu = 0;
        if (hipGetDevice(&dev) != hipSuccess || hipDeviceGetAttribute(&cus, hipDeviceAttributeMultiprocessorCount, dev) != hipSuccess) { grid = -1; return; }
        if (hipFuncSetAttribute((const void*)fwd_kernel, hipFuncAttributeMaxDynamicSharedMemorySize, LDS_BYTES) != hipSuccess) { fprintf(stderr, "kernel_launch: hipFuncSetAttribute failed\n"); grid = -1; return; }
        if (hipOccupancyMaxActiveBlocksPerMultiprocessor(&per_cu, (const void*)fwd_kernel, 512, LDS_BYTES) != hipSuccess || per_cu < 1) { fprintf(stderr, "kernel_launch: occupancy query reports %d\n", per_cu); }
        (void)hipGetLastError();
        grid = cus;
        if (grid != 256) { fprintf(stderr, "kernel_launch: %d CUs; this kernel is laid out for 256\n", grid); grid = -1; return; }
    }
    if (grid < 0) return;
    if (hipMemsetAsync((char*)d_ws + WS_CTL, 0, CTL_ZERO_BYTES, stream) != hipSuccess) return;
    Args a{};
    a.x = (const float*)d_in[0]; a.n1g = (const float*)d_in[1]; a.wgu1 = (const float*)d_in[2]; a.wdn1 = (const float*)d_in[3]; a.mng = (const float*)d_in[4];
    a.win = (const float*)d_in[5]; a.bin = (const float*)d_in[6]; a.convw = (const float*)d_in[7]; a.hng = (const float*)d_in[8]; a.pa = (const float*)d_in[9];
    a.wpool = (const float*)d_in[10]; a.pscale = (const float*)d_in[11]; a.pb = (const float*)d_in[12]; a.wout = (const float*)d_in[13]; a.n2g = (const float*)d_in[14];
    a.wgu2 = (const float*)d_in[15]; a.wdn2 = (const float*)d_in[16]; a.fng = (const float*)d_in[17];
    a.out = (float*)d_out; a.ws = (unsigned char*)d_ws;
    if (MK_N_LAUNCHES == 1) { a.ph_lo = 0; a.ph_hi = NPHASE; hipLaunchKernelGGL(fwd_kernel, dim3(grid), dim3(512), LDS_BYTES, stream, a); }
    else for (int p = 0; p < NPHASE; ++p) { a.ph_lo = p; a.ph_hi = p + 1; hipLaunchKernelGGL(fwd_kernel, dim3(grid), dim3(512), LDS_BYTES, stream, a); }
}
```

```cpp
#include <hip/hip_runtime.h>
#include <cstdio>

#ifndef MK_N_LAUNCHES
#define MK_N_LAUNCHES 1
#endif
#define LAS __attribute__((address_space(3)))
#define GAS __attribute__((address_space(1)))
typedef unsigned short bf16_t;
typedef short bf16x8 __attribute__((ext_vector_type(8)));
typedef float f32x4 __attribute__((ext_vector_type(4)));
typedef float f32x2 __attribute__((ext_vector_type(2)));
typedef unsigned u32x4 __attribute__((ext_vector_type(4)));
typedef unsigned u32x2 __attribute__((ext_vector_type(2)));
typedef GAS unsigned gu32;

constexpr int BATCH = 8, SEQ = 8192, D = 1024, M = BATCH * SEQ, DFF = 2816, NGU = 2 * DFF;
constexpr int NH = 4, DH = 128, CH = 64, NCH = SEQ / CH, NUNIT = BATCH * NCH * NH;
constexpr int DIN = 4616, NIN = 4864, ZW = 4608;
constexpr int ZC_Q = 0, ZC_K = 512, ZC_V = 1024, ZC_O = 1536, ZC_U = 2048, ZC_GA = 2560, ZC_GB = 3584;
constexpr float EPS = 1e-6f;
constexpr int NPHASE = 12;

constexpr size_t MiB = 1u << 20;
constexpr size_t WS_CTL = 0, CTL_ZERO_BYTES = 1 * MiB;
constexpr size_t WS_WGU1 = 1 * MiB;
constexpr size_t WS_WDN1 = WS_WGU1 + (size_t)NGU * D * 2;
constexpr size_t WS_WIN = WS_WDN1 + (size_t)D * DFF * 2;
constexpr size_t WS_WAB = WS_WIN + (size_t)NIN * D * 2;
constexpr size_t WS_WOUT = WS_WAB + (size_t)D * D * 2;
constexpr size_t WS_WGU2 = WS_WOUT + (size_t)D * D * 2;
constexpr size_t WS_WDN2 = WS_WGU2 + (size_t)NGU * D * 2;
constexpr size_t WS_WEND = WS_WDN2 + (size_t)D * DFF * 2;
constexpr size_t WS_SS = 48 * MiB;
constexpr size_t WS_ZIF = 49 * MiB;
constexpr size_t WS_NST = 51 * MiB;
constexpr size_t WS_UB = 53 * MiB, WS_UM = WS_UB + 65536, WS_UMS = WS_UM + 65536;
constexpr size_t WS_NST2 = 54 * MiB;
constexpr size_t WS_H = 64 * MiB;
constexpr size_t WS_A2 = 192 * MiB;
constexpr size_t WS_CST = 320 * MiB;
constexpr size_t WS_Z = 448 * MiB;
constexpr size_t WS_END = 1024 * MiB;
static_assert(WS_WEND <= WS_SS && WS_Z + (size_t)M * ZW * 2 <= WS_END && WS_CST + (size_t)NUNIT * DH * DH * 2 <= WS_Z, "ws map");
constexpr int CW_TMO = 0, CW_BAR = 4096;

constexpr int RING_BYTES = 131072, EPI_OFF = RING_BYTES, EPI_BYTES = 4096, LDS_BYTES = 147456, MISC_OFF = LDS_BYTES - 256;

#define RLX_AGENT __ATOMIC_RELAXED, __HIP_MEMORY_SCOPE_AGENT
typedef __bf16 bf16x2_t __attribute__((ext_vector_type(2)));
__device__ __forceinline__ unsigned cvt_pk_bf16(float lo, float hi) { const f32x2 v = {lo, hi}; return __builtin_bit_cast(unsigned, __builtin_convertvector(v, bf16x2_t)); }
__device__ __forceinline__ bf16_t f2bf_s(float x) { return (bf16_t)(cvt_pk_bf16(x, 0.f) & 0xffffu); }
__device__ __forceinline__ float bf_lo(unsigned w) { return __uint_as_float(w << 16); }
__device__ __forceinline__ float bf_hi(unsigned w) { return __uint_as_float(w & 0xffff0000u); }
__device__ __forceinline__ float fast_exp(float x) { return __builtin_amdgcn_exp2f(x * 1.44269504089f); }
__device__ __forceinline__ float fast_sigmoid(float x) { return __builtin_amdgcn_rcpf(1.0f + fast_exp(-x)); }

#define XB_TMO      128
#define XB_XCNT(j)  (256  + 64 * (j))
#define XB_XSUB(j)  (1280 + 64 * (j))
#define XB_XGEN(j)  (2304 + 64 * (j))
#define XB_TOP      3328
#define XB_TOPGEN   3392
#define XCD_BAR_WORDS 3456
#define XB_SPIN_CAP (1u << 18)
__device__ __forceinline__ unsigned xb_ld(unsigned* p)              { return __hip_atomic_load(p, __ATOMIC_RELAXED, __HIP_MEMORY_SCOPE_AGENT); }
__device__ __forceinline__ unsigned xb_add(unsigned* p, unsigned v) { return __hip_atomic_fetch_add(p, v, __ATOMIC_RELAXED, __HIP_MEMORY_SCOPE_AGENT); }
__device__ __forceinline__ unsigned xb_xcc_id() { return (unsigned)__builtin_amdgcn_s_getreg((3 << 11) | 20) & 0xFu; }
#define XB_SPIN(cond, bar) do { unsigned _sp = 0; while (cond) { __builtin_amdgcn_s_sleep(1); \
    if ((++_sp & 255u) == 0u) { if (xb_ld(&(bar)[XB_TMO])) break; if (_sp > XB_SPIN_CAP) { atomicAdd(&(bar)[XB_TMO], 1u); break; } } } } while (0)
struct XcdBarrier { unsigned* bar; unsigned x; volatile LAS unsigned* st; };
__device__ __forceinline__ XcdBarrier xcd_barrier_post(unsigned* bar, volatile LAS unsigned* st) {
    XcdBarrier b; b.bar = bar; b.x = xb_xcc_id(); b.st = st;
    if (threadIdx.x == 0) (void)xb_add(&bar[XB_XCNT(b.x)], 1u);
    return b;
}
__device__ __forceinline__ void xcd_barrier_complete(unsigned* bar, unsigned x, unsigned& nloc, unsigned& nx) {
    const unsigned G = gridDim.x * gridDim.y * gridDim.z;
    unsigned sum, cnt, mine, sp = 0u;
    for (;;) {
        sum = 0u; cnt = 0u; mine = 0u;
#pragma unroll
        for (unsigned j = 0; j < 16; ++j) { const unsigned c = xb_ld(&bar[XB_XCNT(j)]); sum += c; cnt += (c > 0u) ? 1u : 0u; mine = (j == x) ? c : mine; }
        if (sum == G) break;
        __builtin_amdgcn_s_sleep(1);
        if ((++sp & 255u) == 0u) { if (xb_ld(&bar[XB_TMO])) break; if (sp > XB_SPIN_CAP) { atomicAdd(&bar[XB_TMO], 1u); break; } }
    }
    nloc = mine > 0u ? mine : 1u; nx = cnt > 0u ? cnt : 1u;
}
__device__ __forceinline__ void xcd_barrier(const XcdBarrier& b) {
    asm volatile("s_waitcnt vmcnt(0)" ::: "memory");
    __syncthreads();
    if (threadIdx.x == 0) {
        unsigned* bar = b.bar;
        __builtin_amdgcn_s_waitcnt(0);
        unsigned nloc = b.st[0], nx = b.st[1];
        if (nloc == 0u) { xcd_barrier_complete(bar, b.x, nloc, nx); b.st[0] = nloc; b.st[1] = nx; }
        const unsigned old = xb_add(&bar[XB_XSUB(b.x)], 1u);
        const unsigned gen = old / nloc;
        if (old + 1u == (gen + 1u) * nloc) {
            __builtin_amdgcn_fence(__ATOMIC_RELEASE, "agent");
            asm volatile("s_waitcnt vmcnt(0)" ::: "memory");
            const unsigned og = xb_add(&bar[XB_TOP], 1u);
            const unsigned tg = og / nx;
            if (og + 1u == (tg + 1u) * nx) xb_add(&bar[XB_TOPGEN], 1u);
            else XB_SPIN(xb_ld(&bar[XB_TOPGEN]) == tg, bar);
            __builtin_amdgcn_fence(__ATOMIC_ACQUIRE, "agent");
            xb_add(&bar[XB_XGEN(b.x)], 1u);
            asm volatile("s_waitcnt vmcnt(0)" ::: "memory");
        } else {
            XB_SPIN(xb_ld(&bar[XB_XGEN(b.x)]) == gen, bar);
            __builtin_amdgcn_fence(__ATOMIC_ACQUIRE, "agent");
            asm volatile("s_waitcnt vmcnt(0)" ::: "memory");
        }
    }
    __syncthreads();
}

namespace pg8 {
constexpr int BM = 256, BK = 64, HALF = 128, HTB = HALF * BK * 2, STAGE_BYTES = 8 * HTB, NXCD = 8, WGM = 4;
__host__ __device__ __forceinline__ int lds_byte(int r, int c) { const int st = (r >> 4) * 2 + (c >> 5), rr = r & 15, cc = c & 31, ob = rr * 64 + cc * 2; return st * 1024 + (ob ^ (((ob >> 9) & 1) << 5)); }
__host__ __device__ __forceinline__ void stage_rc(int b, int& R, int& C) { const int st = b / 1024, sb = b % 1024, swz = sb ^ (((sb >> 9) & 1) << 5); R = (st >> 1) * 16 + swz / 64; C = (st & 1) * 32 + (swz % 64) / 2; }
__host__ __device__ __forceinline__ int perm32(int rho) { const int n = rho >> 4, i = rho & 15; return 8 * (i >> 2) + 4 * n + (i & 3); }
struct Unit { int pm, pn; };
struct Gemm { const bf16_t* A; const bf16_t* Bt; int M, N, K, lda, ldb; };
struct StaticOrder {
    int nM, nN, nwg, G, c;
    __host__ __device__ void init(int M_, int N_, int G_, int c_) { nM = M_ / BM; nN = N_ / BM; nwg = nM * nN; G = G_; c = c_; }
    __host__ __device__ bool next(int i, Unit& u) const {
        const long L = (long)i * G + c; if (L >= nwg) return false;
        int wgid = (int)L; { const int q = nwg / NXCD, r = nwg % NXCD, xcd = wgid % NXCD, off = wgid / NXCD; wgid = (xcd < r ? xcd * (q + 1) : r * (q + 1) + (xcd - r) * q) + off; }
        const int nig = WGM * nN, gid = wgid / nig, fm = gid * WGM, gsz = (nM - fm) < WGM ? (nM - fm) : WGM;
        u.pm = fm + ((wgid % nig) % gsz); u.pn = (wgid % nig) / gsz; return true;
    }
};
template <class Epi, bool ALIGN_EPI>
__device__ __forceinline__ void gemm_phase(LAS unsigned char* lds, const Gemm g, const StaticOrder& S, const Epi& E) {
    const int tid = threadIdx.x, wid = __builtin_amdgcn_readfirstlane(tid >> 6), lane = tid & 63, wr = wid >> 2, wc = wid & 3, fr = lane & 15, fq = lane >> 4;
    const int K = g.K, nt = K / BK;
    unsigned voffA[2], voffB[2];
#pragma unroll
    for (int i = 0; i < 2; ++i) { int R, C; stage_rc(tid * 16 + i * 8192, R, C); const int Rb = (R & ~31) + perm32(R & 31);
        voffA[i] = (unsigned)(R * g.lda + C) * 2u; voffB[i] = (unsigned)(Rb * g.ldb + C) * 2u; }
    const size_t kstep = (size_t)(BK * 2);
    const size_t hstepA = (size_t)HALF * g.lda * 2, hstepB = (size_t)HALF * g.ldb * 2;
    const size_t tstepA = 2 * hstepA, tstepB = 2 * hstepB;
    const unsigned ldsw = (unsigned)wid * 1024u;
    const int aoff = lds_byte(wr * 64 + fr, fq * 8), boff = lds_byte(wc * 32 + fr, fq * 8);
#define PG8_SA(b, h) (((b) * 2 + (h)) * HTB)
#define PG8_SB(b, h) ((4 + (b) * 2 + (h)) * HTB)
#define PG8_STAGE(bufoff, gbase, voff) do { _Pragma("unroll") for (int _i = 0; _i < 2; ++_i) \
        __builtin_amdgcn_global_load_lds((const unsigned*)((const char*)(gbase) + (voff)[_i]), (LAS unsigned*)(lds + (bufoff) + ldsw + _i * 8192), 16, 0, 0); } while (0)
#define PG8_LDA(dst, b, h) do { _Pragma("unroll") for (int m = 0; m < 4; ++m) _Pragma("unroll") for (int k = 0; k < 2; ++k) dst[m][k] = *(const LAS bf16x8*)(lds + PG8_SA(b, h) + aoff + m * 2048 + k * 1024); } while (0)
#define PG8_LDB(dst, b, h) do { _Pragma("unroll") for (int n = 0; n < 2; ++n) _Pragma("unroll") for (int k = 0; k < 2; ++k) dst[n][k] = *(const LAS bf16x8*)(lds + PG8_SB(b, h) + boff + n * 2048 + k * 1024); } while (0)
#define PG8_MMA(ai, bj, At, Bt) do { __builtin_amdgcn_s_setprio(1); _Pragma("unroll") for (int m = 0; m < 4; ++m) _Pragma("unroll") for (int n = 0; n < 2; ++n) _Pragma("unroll") for (int k = 0; k < 2; ++k) \
        acc[ai][bj][m][n] = __builtin_amdgcn_mfma_f32_16x16x32_bf16(Bt[n][k], At[m][k], acc[ai][bj][m][n], 0, 0, 0); __builtin_amdgcn_s_setprio(0); } while (0)
#define PG8_WAIT_V(n) asm volatile("s_waitcnt vmcnt(" #n ")" ::: "memory")
#define PG8_WAIT_L(n) asm volatile("s_waitcnt lgkmcnt(" #n ")" ::: "memory")
#define PG8_BAR __builtin_amdgcn_s_barrier()
#define PG8_SCHED __builtin_amdgcn_sched_barrier(0)
    Unit cur, nxt; int ui = 0;
    if (!S.next(0, cur)) return;
    f32x4 acc[2][2][4][2];
#pragma unroll
    for (int a = 0; a < 2; ++a)
#pragma unroll
        for (int b = 0; b < 2; ++b)
#pragma unroll
            for (int m = 0; m < 4; ++m)
#pragma unroll
                for (int n = 0; n < 2; ++n) acc[a][b][m][n] = (f32x4){0.f, 0.f, 0.f, 0.f};
    bf16x8 At[4][2], B0[2][2], B1[2][2];
    const char* cA = (const char*)g.A + (size_t)cur.pm * tstepA; const char* cB = (const char*)g.Bt + (size_t)cur.pn * tstepB;
    PG8_STAGE(PG8_SB(0, 0), cB, voffB); PG8_STAGE(PG8_SB(0, 1), cB + hstepB, voffB); PG8_STAGE(PG8_SA(0, 0), cA, voffA); PG8_STAGE(PG8_SA(0, 1), cA + hstepA, voffA);
    if (wr == 1) PG8_BAR;
    PG8_WAIT_V(2); PG8_BAR;
    PG8_STAGE(PG8_SB(1, 0), cB + kstep, voffB); PG8_STAGE(PG8_SA(1, 0), cA + kstep, voffA); PG8_STAGE(PG8_SB(1, 1), cB + hstepB + kstep, voffB);
    PG8_WAIT_V(6); PG8_BAR;
    for (;;) {
        const bool has_next = S.next(ui + 1, nxt);
        const char* nA = has_next ? (const char*)g.A + (size_t)nxt.pm * tstepA : cA; const char* nB = has_next ? (const char*)g.Bt + (size_t)nxt.pn * tstepB : cB;
        for (int t = 0; t < nt; t += 2) {
            const bool last = (t == nt - 2);
            const char* a1 = cA + (size_t)(t + 1) * kstep;
            const char* a2 = last ? nA : cA + (size_t)(t + 2) * kstep; const char* b2 = last ? nB : cB + (size_t)(t + 2) * kstep;
            const char* a3 = a2 + kstep; const char* b3 = b2 + kstep;
            PG8_LDB(B0, 0, 0); PG8_LDB(B1, 0, 1); PG8_SCHED; PG8_LDA(At, 0, 0); PG8_STAGE(PG8_SA(1, 1), a1 + hstepA, voffA);
            PG8_WAIT_V(8); PG8_WAIT_L(0); PG8_BAR; PG8_MMA(0, 0, At, B0); PG8_MMA(0, 1, At, B1); PG8_BAR; PG8_SCHED;
            PG8_LDA(At, 0, 1); PG8_STAGE(PG8_SB(0, 0), b2, voffB); PG8_STAGE(PG8_SB(0, 1), b2 + hstepB, voffB); PG8_STAGE(PG8_SA(0, 0), a2, voffA);
            PG8_WAIT_V(8); PG8_WAIT_L(0); PG8_BAR; PG8_MMA(1, 0, At, B0); PG8_MMA(1, 1, At, B1); PG8_BAR; PG8_SCHED;
            PG8_LDB(B0, 1, 0); PG8_LDB(B1, 1, 1); PG8_SCHED; PG8_LDA(At, 1, 0); PG8_STAGE(PG8_SA(0, 1), a2 + hstepA, voffA);
            PG8_WAIT_V(8); PG8_WAIT_L(0); PG8_BAR; PG8_MMA(0, 0, At, B0); PG8_MMA(0, 1, At, B1); PG8_BAR; PG8_SCHED;
            PG8_LDA(At, 1, 1); PG8_STAGE(PG8_SB(1, 0), b3, voffB); PG8_STAGE(PG8_SB(1, 1), b3 + hstepB, voffB); PG8_STAGE(PG8_SA(1, 0), a3, voffA);
            PG8_WAIT_V(8); PG8_WAIT_L(0); PG8_BAR; PG8_MMA(1, 0, At, B0); PG8_MMA(1, 1, At, B1); PG8_BAR; PG8_SCHED;
        }
        if constexpr (ALIGN_EPI) { if (wr == 0) PG8_BAR; }
        E(acc, cur, wid, wr, wc, fr, fq);
        if (!has_next) break;
#pragma unroll
        for (int a = 0; a < 2; ++a)
#pragma unroll
            for (int b = 0; b < 2; ++b)
#pragma unroll
                for (int m = 0; m < 4; ++m)
#pragma unroll
                    for (int n = 0; n < 2; ++n) acc[a][b][m][n] = (f32x4){0.f, 0.f, 0.f, 0.f};
        cur = nxt; cA = nA; cB = nB; ++ui;
        if constexpr (ALIGN_EPI) { if (wr == 1) PG8_BAR; }
    }
    PG8_WAIT_V(0);
    if constexpr (!ALIGN_EPI) { if (wr == 0) PG8_BAR; }
    PG8_BAR;
#undef PG8_SA
#undef PG8_SB
#undef PG8_STAGE
#undef PG8_LDA
#undef PG8_LDB
#undef PG8_MMA
#undef PG8_WAIT_V
#undef PG8_WAIT_L
#undef PG8_BAR
#undef PG8_SCHED
}

typedef const f32x4 (&AccRef)[2][2][4][2];
__device__ __forceinline__ void load_rs8(const float* ss, int row0, float (&r)[8]) {
    float p[8][4];
#pragma unroll
    for (int i = 0; i < 8; ++i)
#pragma unroll
        for (int q = 0; q < 4; ++q) p[i][q] = ss[(size_t)q * M + row0 + (i >> 2) * HALF + (i & 3) * 16];
    asm volatile("" ::: "memory");
#pragma unroll
    for (int i = 0; i < 8; ++i) r[i] = __builtin_amdgcn_rsqf(((p[i][0] + p[i][1]) + (p[i][2] + p[i][3])) * (1.0f / D) + EPS);
}
template <bool RS> struct EpiSwiGLU {
    bf16_t* act; const float* ss;
    __device__ __forceinline__ void operator()(AccRef acc, const Unit& u, int wid, int wr, int wc, int fr, int fq) const {
        const int row0 = u.pm * BM + wr * 64 + fr, col0 = u.pn * HALF + wc * 32 + 8 * fq;
        float rs[8];
        if constexpr (RS) load_rs8(ss, row0, rs); else {
#pragma unroll
            for (int i = 0; i < 8; ++i) rs[i] = 1.0f; }
#pragma unroll
        for (int ai = 0; ai < 2; ++ai)
#pragma unroll
            for (int m = 0; m < 4; ++m) {
                const int row = row0 + ai * HALF + m * 16; const float r = rs[ai * 4 + m]; float o[8];
#pragma unroll
                for (int n = 0; n < 2; ++n)
#pragma unroll
                    for (int j = 0; j < 4; ++j) { const float gt = acc[ai][0][m][n][j] * r, up = acc[ai][1][m][n][j] * r; o[n * 4 + j] = gt * fast_sigmoid(gt) * up; }
                u32x4 w; w.x = cvt_pk_bf16(o[0], o[1]); w.y = cvt_pk_bf16(o[2], o[3]); w.z = cvt_pk_bf16(o[4], o[5]); w.w = cvt_pk_bf16(o[6], o[7]);
                *(u32x4*)(act + (size_t)row * DFF + col0) = w;
            }
    }
};
template <bool BASE_BF16, bool OUT_BF16> struct EpiResid {
    const void* base; void* out; float* ss; float alpha; LAS float* P;
    __device__ __forceinline__ void operator()(AccRef acc, const Unit& u, int wid, int wr, int wc, int fr, int fq) const {
        const int rl0 = wr * 64 + fr, col0 = u.pn * BM + wc * 32 + 8 * fq;
        u32x4 bb[2][4][2];
        if constexpr (BASE_BF16) {
#pragma unroll
            for (int ai = 0; ai < 2; ++ai)
#pragma unroll
                for (int m = 0; m < 4; ++m)
#pragma unroll
                    for (int bj = 0; bj < 2; ++bj) bb[ai][m][bj] = *(const u32x4*)((const bf16_t*)base + (size_t)(u.pm * BM + rl0 + ai * HALF + m * 16) * D + col0 + bj * HALF);
            asm volatile("" ::: "memory");
        }
#pragma unroll
        for (int ai = 0; ai < 2; ++ai) {
            f32x4 b[4][2][2];
            if constexpr (!BASE_BF16) {
#pragma unroll
                for (int m = 0; m < 4; ++m)
#pragma unroll
                    for (int bj = 0; bj < 2; ++bj) { const size_t off = (size_t)(u.pm * BM + rl0 + ai * HALF + m * 16) * D + col0 + bj * HALF;
                        b[m][bj][0] = *(const f32x4*)((const float*)base + off); b[m][bj][1] = *(const f32x4*)((const float*)base + off + 4); }
                asm volatile("" ::: "memory");
            } else {
#pragma unroll
                for (int m = 0; m < 4; ++m)
#pragma unroll
                    for (int bj = 0; bj < 2; ++bj) { const u32x4 q = bb[ai][m][bj];
                        b[m][bj][0] = (f32x4){bf_lo(q.x), bf_hi(q.x), bf_lo(q.y), bf_hi(q.y)}; b[m][bj][1] = (f32x4){bf_lo(q.z), bf_hi(q.z), bf_lo(q.w), bf_hi(q.w)}; }
            }
#pragma unroll
            for (int m = 0; m < 4; ++m) {
                const int rl = rl0 + ai * HALF + m * 16; const size_t off = (size_t)(u.pm * BM + rl) * D + col0; float s = 0.f;
#pragma unroll
                for (int bj = 0; bj < 2; ++bj) {
                    const f32x4 v0 = b[m][bj][0] + acc[ai][bj][m][0] * alpha, v1 = b[m][bj][1] + acc[ai][bj][m][1] * alpha;
                    if constexpr (OUT_BF16) { u32x4 w; w.x = cvt_pk_bf16(v0[0], v0[1]); w.y = cvt_pk_bf16(v0[2], v0[3]); w.z = cvt_pk_bf16(v1[0], v1[1]); w.w = cvt_pk_bf16(v1[2], v1[3]); *(u32x4*)((bf16_t*)out + off + bj * HALF) = w; }
                    else { *(f32x4*)((float*)out + off + bj * HALF) = v0; *(f32x4*)((float*)out + off + bj * HALF + 4) = v1; }
                    s += (v0[0] * v0[0] + v0[1] * v0[1]) + (v0[2] * v0[2] + v0[3] * v0[3]) + (v1[0] * v1[0] + v1[1] * v1[1]) + (v1[2] * v1[2] + v1[3] * v1[3]);
                }
                if (ss) { s += __shfl_xor(s, 16); s += __shfl_xor(s, 32); if (fq == 0) P[rl * 4 + wc] = s; }
            }
        }
        if (ss) {
            asm volatile("s_waitcnt lgkmcnt(0)" ::: "memory"); __builtin_amdgcn_s_barrier(); asm volatile("" ::: "memory");
            const int t = threadIdx.x;
            if (t < 256) { const f32x4 p = *(const LAS f32x4*)(P + t * 4); ss[(size_t)u.pn * M + u.pm * BM + t] = (p[0] + p[1]) + (p[2] + p[3]); }
        }
    }
};
struct EpiWin {
    bf16_t* z; float* zif; const float* bias; const float* ss;
    __device__ __forceinline__ void operator()(AccRef acc, const Unit& u, int wid, int wr, int wc, int fr, int fq) const {
        const int row0 = u.pm * BM + wr * 64 + fr, col0 = u.pn * BM + wc * 32 + 8 * fq;
        float rs[8]; load_rs8(ss, row0, rs);
        if (u.pn == 18) {
            if (wc == 0 && fq == 0) {
                const f32x4 bi = *(const f32x4*)(bias + ZW), bf = *(const f32x4*)(bias + ZW + 4);
#pragma unroll
                for (int ai = 0; ai < 2; ++ai)
#pragma unroll
                    for (int m = 0; m < 4; ++m) {
                        const int row = row0 + ai * HALF + m * 16; const float r = rs[ai * 4 + m];
                        const f32x4 vi = acc[ai][0][m][0] * r + bi, vf = acc[ai][0][m][1] * r + bf; f32x4 lf;
#pragma unroll
                        for (int j = 0; j < 4; ++j) { const float x = vf[j]; lf[j] = fminf(x, 0.f) - __logf(1.0f + __expf(-fabsf(x))); }
                        *(f32x4*)(zif + (size_t)row * 8) = vi; *(f32x4*)(zif + (size_t)row * 8 + 4) = lf;
                    }
            }
            return;
        }
        const bool sg = (u.pn == 6) | (u.pn == 7) | (u.pn >= 10);
        f32x4 bv[2][2];
#pragma unroll
        for (int bj = 0; bj < 2; ++bj)
#pragma unroll
            for (int n = 0; n < 2; ++n) bv[bj][n] = *(const f32x4*)(bias + col0 + bj * HALF + 4 * n);
        asm volatile("" ::: "memory");
#pragma unroll
        for (int ai = 0; ai < 2; ++ai)
#pragma unroll
            for (int m = 0; m < 4; ++m) {
                const int row = row0 + ai * HALF + m * 16; const float r = rs[ai * 4 + m];
#pragma unroll
                for (int bj = 0; bj < 2; ++bj) {
                    f32x4 v0 = acc[ai][bj][m][0] * r + bv[bj][0], v1 = acc[ai][bj][m][1] * r + bv[bj][1];
                    if (sg) {
#pragma unroll
                        for (int j = 0; j < 4; ++j) { v0[j] = fast_sigmoid(v0[j]); v1[j] = fast_sigmoid(v1[j]); } }
                    u32x4 w; w.x = cvt_pk_bf16(v0[0], v0[1]); w.y = cvt_pk_bf16(v0[2], v0[3]); w.z = cvt_pk_bf16(v1[0], v1[1]); w.w = cvt_pk_bf16(v1[2], v1[3]);
                    *(u32x4*)(z + (size_t)row * ZW + col0 + bj * HALF) = w;
                }
            }
    }
};
template <bool ADD> struct EpiMerge {
    bf16_t* mg; const bf16_t* z; int gcol0;
    __device__ __forceinline__ void operator()(AccRef acc, const Unit& u, int wid, int wr, int wc, int fr, int fq) const {
        const int row0 = u.pm * BM + wr * 64 + fr, col0 = u.pn * BM + wc * 32 + 8 * fq;
#pragma unroll
        for (int ai = 0; ai < 2; ++ai) {
            u32x4 gt[4][2], pv[4][2];
#pragma unroll
            for (int m = 0; m < 4; ++m)
#pragma unroll
                for (int bj = 0; bj < 2; ++bj) { const int row = row0 + ai * HALF + m * 16;
                    gt[m][bj] = *(const u32x4*)(z + (size_t)row * ZW + gcol0 + col0 + bj * HALF);
                    if (ADD) pv[m][bj] = *(const u32x4*)(mg + (size_t)row * D + col0 + bj * HALF); }
            asm volatile("" ::: "memory");
#pragma unroll
            for (int m = 0; m < 4; ++m)
#pragma unroll
                for (int bj = 0; bj < 2; ++bj) { const int row = row0 + ai * HALF + m * 16; const u32x4 g = gt[m][bj];
                    f32x4 v0 = acc[ai][bj][m][0], v1 = acc[ai][bj][m][1];
                    v0[0] *= bf_lo(g.x); v0[1] *= bf_hi(g.x); v0[2] *= bf_lo(g.y); v0[3] *= bf_hi(g.y);
                    v1[0] *= bf_lo(g.z); v1[1] *= bf_hi(g.z); v1[2] *= bf_lo(g.w); v1[3] *= bf_hi(g.w);
                    if (ADD) { const u32x4 q = pv[m][bj];
                        v0[0] += bf_lo(q.x); v0[1] += bf_hi(q.x); v0[2] += bf_lo(q.y); v0[3] += bf_hi(q.y);
                        v1[0] += bf_lo(q.z); v1[1] += bf_hi(q.z); v1[2] += bf_lo(q.w); v1[3] += bf_hi(q.w); }
                    u32x4 w; w.x = cvt_pk_bf16(v0[0], v0[1]); w.y = cvt_pk_bf16(v0[2], v0[3]); w.z = cvt_pk_bf16(v1[0], v1[1]); w.w = cvt_pk_bf16(v1[2], v1[3]);
                    *(u32x4*)(mg + (size_t)row * D + col0 + bj * HALF) = w; }
        }
    }
};
}

struct Args {
    const float* x; const float* n1g; const float* wgu1; const float* wdn1; const float* mng; const float* win; const float* bin; const float* convw;
    const float* hng; const float* pa; const float* wpool; const float* pscale; const float* pb; const float* wout; const float* n2g; const float* wgu2; const float* wdn2; const float* fng;
    float* out; unsigned char* ws; int ph_lo, ph_hi;
};

__device__ __forceinline__ float wave_sum(float v) {
#pragma unroll
    for (int o = 1; o < 64; o <<= 1) v += __shfl_xor(v, o);
    return v;
}
__device__ __forceinline__ float wave_max(float v) {
#pragma unroll
    for (int o = 1; o < 64; o <<= 1) v = fmaxf(v, __shfl_xor(v, o));
    return v;
}
__device__ __forceinline__ void transpose_item(const float* W, int N, int nvalid, const float* gain, bf16_t* WT, int ldt, int k0, int n0, int drow0, LAS float* scr, int lane) {
    const int n = n0 + (lane & 31); const bool ok = n < nvalid; float v[32];
#pragma unroll
    for (int i = 0; i < 32; ++i) { v[i] = 0.f; if (ok) v[i] = W[(size_t)(k0 + 2 * i + (lane >> 5)) * N + n]; }
    const int c = lane & 7;
    f32x4 g0 = {1.f, 1.f, 1.f, 1.f}, g1 = g0; if (gain) { g0 = *(const f32x4*)(gain + k0 + 8 * c); g1 = *(const f32x4*)(gain + k0 + 8 * c + 4); }
#pragma unroll
    for (int i = 0; i < 32; ++i) scr[(2 * i + (lane >> 5)) * 33 + (lane & 31)] = v[i];
    asm volatile("s_waitcnt lgkmcnt(0)" ::: "memory");
#pragma unroll
    for (int j = 0; j < 4; ++j) { const int nn = (lane >> 3) + 8 * j; const LAS float* sp = scr + (8 * c) * 33 + nn;
        u32x4 o; o.x = cvt_pk_bf16(sp[0 * 33] * g0[0], sp[1 * 33] * g0[1]); o.y = cvt_pk_bf16(sp[2 * 33] * g0[2], sp[3 * 33] * g0[3]);
        o.z = cvt_pk_bf16(sp[4 * 33] * g1[0], sp[5 * 33] * g1[1]); o.w = cvt_pk_bf16(sp[6 * 33] * g1[2], sp[7 * 33] * g1[3]);
        *(u32x4*)(WT + (size_t)(drow0 + nn) * ldt + k0 + 8 * c) = o; }
    asm volatile("s_waitcnt lgkmcnt(0)" ::: "memory");
}
__device__ __forceinline__ int gu_row(int n0) {
    const int isup = n0 >= DFF, nn = isup ? n0 - DFF : n0; return 256 * (nn >> 7) + (isup ? 128 : 0) + (nn & 127);
}

__device__ __forceinline__ void p0_prologue(const Args& a, LAS unsigned char* lds, int gw, int NGW, int lane, int wave) {
    unsigned char* ws = a.ws;
    LAS float* scr = (LAS float*)(lds + wave * 16384);
    constexpr int I_GU = (D / 64) * (NGU / 32), I_DN = (DFF / 64) * (D / 32), I_IN = (D / 64) * (NIN / 32), I_PA = (512 / 64) * (D / 32), I_WO = (D / 64) * (D / 32);
    constexpr int NITEMS = 2 * I_GU + 2 * I_DN + I_IN + I_PA + I_WO;
    for (int it = gw; it < NITEMS; it += NGW) {
        int r = it;
        if (r < I_GU) { const int nb = r % (NGU / 32), kb = r / (NGU / 32); transpose_item(a.wgu1, NGU, NGU, a.n1g, (bf16_t*)(ws + WS_WGU1), D, kb * 64, nb * 32, gu_row(nb * 32) - 0, scr, lane); continue; } r -= I_GU;
        if (r < I_GU) { const int nb = r % (NGU / 32), kb = r / (NGU / 32); transpose_item(a.wgu2, NGU, NGU, a.n2g, (bf16_t*)(ws + WS_WGU2), D, kb * 64, nb * 32, gu_row(nb * 32) - 0, scr, lane); continue; } r -= I_GU;
        if (r < I_DN) { const int nb = r % (D / 32), kb = r / (D / 32); transpose_item(a.wdn1, D, D, nullptr, (bf16_t*)(ws + WS_WDN1), DFF, kb * 64, nb * 32, nb * 32, scr, lane); continue; } r -= I_DN;
        if (r < I_DN) { const int nb = r % (D / 32), kb = r / (D / 32); transpose_item(a.wdn2, D, D, nullptr, (bf16_t*)(ws + WS_WDN2), DFF, kb * 64, nb * 32, nb * 32, scr, lane); continue; } r -= I_DN;
        if (r < I_IN) { const int nb = r % (NIN / 32), kb = r / (NIN / 32); transpose_item(a.win, DIN, DIN, a.mng, (bf16_t*)(ws + WS_WIN), D, kb * 64, nb * 32, nb * 32, scr, lane); continue; } r -= I_IN;
        if (r < I_PA) { const int nb = r % (D / 32), kb = r / (D / 32); transpose_item(a.pa, D, D, nullptr, (bf16_t*)(ws + WS_WAB), D, kb * 64, nb * 32, nb * 32, scr, lane); continue; } r -= I_PA;
        { const int nb = r % (D / 32), kb = r / (D / 32); transpose_item(a.wout, D, D, nullptr, (bf16_t*)(ws + WS_WOUT), D, kb * 64, nb * 32, nb * 32, scr, lane); }
    }
    {
        bf16_t* wab = (bf16_t*)(ws + WS_WAB);
        const int o = gw * 64 + lane;
        if (o < 128 * D) {
            const int n = o & (D - 1), c = o >> 10; float acc4[4] = {0.f, 0.f, 0.f, 0.f};
            for (int d0 = 0; d0 < 128; d0 += 8) {
#pragma unroll
                for (int g = 0; g < 4; ++g) {
                    const f32x4 w0 = *(const f32x4*)(a.wpool + (size_t)(g * 128 + c) * 128 + d0), w1 = *(const f32x4*)(a.wpool + (size_t)(g * 128 + c) * 128 + d0 + 4);
                    const f32x4 p0 = *(const f32x4*)(a.pscale + g * 128 + d0), p1 = *(const f32x4*)(a.pscale + g * 128 + d0 + 4);
                    const float* pb = a.pb + (size_t)(g * 128 + d0) * D + n; float bv[8];
#pragma unroll
                    for (int e = 0; e < 8; ++e) bv[e] = pb[(size_t)e * D];
                    acc4[g] += (w0[0] * p0[0] * bv[0] + w0[1] * p0[1] * bv[1]) + (w0[2] * p0[2] * bv[2] + w0[3] * p0[3] * bv[3])
                             + (w1[0] * p1[0] * bv[4] + w1[1] * p1[1] * bv[5]) + (w1[2] * p1[2] * bv[6] + w1[3] * p1[3] * bv[7]);
                }
            }
#pragma unroll
            for (int g = 0; g < 4; ++g) wab[(size_t)n * D + 512 + g * 128 + c] = f2bf_s(acc4[g]);
        }
    }
    {
        bf16_t* hb = (bf16_t*)(ws + WS_H); float* ss = (float*)(ws + WS_SS);
        for (int m0 = gw * 4; m0 < M; m0 += NGW * 4) {
            f32x4 v[4][4]; float sq[4];
#pragma unroll
            for (int q = 0; q < 4; ++q) { const f32x4* xr = (const f32x4*)(a.x + (size_t)(m0 + q) * D) + lane;
#pragma unroll
                for (int j = 0; j < 4; ++j) v[q][j] = xr[64 * j]; }
#pragma unroll
            for (int q = 0; q < 4; ++q) { float t = 0.f;
#pragma unroll
                for (int j = 0; j < 4; ++j) t += (v[q][j][0] * v[q][j][0] + v[q][j][1] * v[q][j][1]) + (v[q][j][2] * v[q][j][2] + v[q][j][3] * v[q][j][3]);
                sq[q] = wave_sum(t); }
#pragma unroll
            for (int q = 0; q < 4; ++q) { const float r = __builtin_amdgcn_rsqf(sq[q] * (1.0f / D) + EPS);
                u32x2* o8 = (u32x2*)(hb + (size_t)(m0 + q) * D) + lane;
#pragma unroll
                for (int j = 0; j < 4; ++j) { u32x2 w; w.x = cvt_pk_bf16(v[q][j][0] * r, v[q][j][1] * r); w.y = cvt_pk_bf16(v[q][j][2] * r, v[q][j][3] * r); o8[64 * j] = w; } }
            if (lane < 16) { const int q = lane >> 2, pp = lane & 3; ss[(size_t)pp * M + m0 + q] = pp == 0 ? (q == 0 ? sq[0] : q == 1 ? sq[1] : q == 2 ? sq[2] : sq[3]) : 0.f; }
        }
    }
}

constexpr int QP = 136, TP = 72;
__device__ __forceinline__ bf16x8 ldfrag(const LAS bf16_t* base, int pitch, int row, int kofs) { return *(const LAS bf16x8*)(base + row * pitch + kofs); }
__device__ __forceinline__ float silu_f(float x) { return x * fast_sigmoid(x); }
__device__ __forceinline__ void unpack8(const u32x4 v, float (&f)[8]) { f[0] = bf_lo(v.x); f[1] = bf_hi(v.x); f[2] = bf_lo(v.y); f[3] = bf_hi(v.y); f[4] = bf_lo(v.z); f[5] = bf_hi(v.z); f[6] = bf_lo(v.w); f[7] = bf_hi(v.w); }
__device__ __forceinline__ void load_taps(const bf16_t* z, int r0, int s, int seq0, int col, u32x4 (&t)[4]) {
#pragma unroll
    for (int j = 0; j < 4; ++j) { const int tt = s - 3 + j; t[j] = (u32x4){0u, 0u, 0u, 0u}; if (seq0 + tt >= 0) t[j] = *(const u32x4*)(z + (size_t)(r0 + tt) * ZW + col); }
}
__device__ __forceinline__ void conv_taps(const u32x4 (&t)[4], const LAS float* cw, int col, float (&o)[8]) {
#pragma unroll
    for (int e = 0; e < 8; ++e) o[e] = 0.f;
#pragma unroll
    for (int j = 0; j < 4; ++j) { float f[8]; unpack8(t[j], f);
        const f32x4 w0 = *(const LAS f32x4*)(cw + j * 1024 + col), w1 = *(const LAS f32x4*)(cw + j * 1024 + col + 4);
        o[0] += w0[0] * f[0]; o[1] += w0[1] * f[1]; o[2] += w0[2] * f[2]; o[3] += w0[3] * f[3];
        o[4] += w1[0] * f[4]; o[5] += w1[1] * f[5]; o[6] += w1[2] * f[6]; o[7] += w1[3] * f[7]; }
#pragma unroll
    for (int e = 0; e < 8; ++e) o[e] = silu_f(o[e]);
}
__device__ __forceinline__ bf16_t f2bf(float x) { return (bf16_t)(cvt_pk_bf16(x, 0.f) & 0xffffu); }

template <int WIN> __device__ __forceinline__ void p4_pool(const LAS bf16_t* Us, bf16_t* a2, int r0, int seq0, int h, int tid) {
#pragma unroll
    for (int it = 0; it < 2; ++it) { const int idx = tid + 512 * it, s = idx >> 4, cg = idx & 15, pos = seq0 + s; const int cnt = pos + 1 < WIN ? pos + 1 : WIN;
        u32x4 rw[WIN];
#pragma unroll
        for (int j = 0; j < WIN; ++j) rw[j] = *(const LAS u32x4*)(Us + (s + 15 - j) * QP + cg * 8);
        float sum[8], cur[8]; unpack8(rw[0], cur);
#pragma unroll
        for (int e = 0; e < 8; ++e) sum[e] = cur[e];
#pragma unroll
        for (int j = 1; j < WIN; ++j) { float f[8]; unpack8(rw[j], f);
#pragma unroll
            for (int e = 0; e < 8; ++e) sum[e] += f[e]; }
        const float inv = 1.0f / (float)cnt;
        u32x4 wv; wv.x = cvt_pk_bf16(sum[0] * inv - cur[0], sum[1] * inv - cur[1]); wv.y = cvt_pk_bf16(sum[2] * inv - cur[2], sum[3] * inv - cur[3]);
        wv.z = cvt_pk_bf16(sum[4] * inv - cur[4], sum[5] * inv - cur[5]); wv.w = cvt_pk_bf16(sum[6] * inv - cur[6], sum[7] * inv - cur[7]);
        *(u32x4*)(a2 + (size_t)(r0 + s) * D + 512 + h * 128 + cg * 8) = wv; }
}
struct P4Regs { u32x4 kt[2][4]; u32x4 vv[2]; u32x4 uu[3]; float lf, ig; };
constexpr int P4_KT = 0, P4_VT = 18432, P4_US = 39168, P4_BUF = 60928, P4_CW = 2 * P4_BUF;
__device__ __forceinline__ void p4_prefetch(const Args& a, int u, P4Regs& R) {
    const bf16_t* z = (const bf16_t*)(a.ws + WS_Z); const float* zif = (const float*)(a.ws + WS_ZIF);
    const int tid = threadIdx.x, lane = tid & 63, wave = tid >> 6;
    const int h = u & 3, c = (u >> 2) & (NCH - 1), b = u >> 9, r0 = b * SEQ + c * CH, seq0 = c * CH;
    R.lf = zif[(size_t)(r0 + lane) * 8 + 4 + h]; R.ig = zif[(size_t)(r0 + lane) * 8 + h];
#pragma unroll
    for (int it = 0; it < 2; ++it) load_taps(z, r0, lane, seq0, ZC_K + h * DH + (wave + 8 * it) * 8, R.kt[it]);
#pragma unroll
    for (int it = 0; it < 2; ++it) R.vv[it] = *(const u32x4*)(z + (size_t)(r0 + lane) * ZW + ZC_V + h * DH + (wave + 8 * it) * 8);
#pragma unroll
    for (int it = 0; it < 3; ++it) { const int idx = tid + 512 * it, row = idx >> 4, cg = idx & 15; R.uu[it] = (u32x4){0u, 0u, 0u, 0u};
        if (idx < 79 * 16 && seq0 - 15 + row >= 0) R.uu[it] = *(const u32x4*)(z + (size_t)(r0 - 15 + row) * ZW + ZC_U + h * 128 + cg * 8); }
}
__device__ __forceinline__ void p4_phase(const Args& a, LAS unsigned char* lds, int vcu) {
    unsigned char* ws = a.ws;
    const int tid = threadIdx.x, lane = tid & 63, wave = tid >> 6, fr = lane & 15, fq = lane >> 4;
    LAS float* cw = (LAS float*)(lds + P4_CW);
    {
#pragma unroll
        for (int it = 0; it < 2; ++it) *(LAS f32x4*)(cw + (tid + 512 * it) * 4) = *(const f32x4*)(a.convw + (tid + 512 * it) * 4);
        for (int i = tid; i < 2 * 16 * TP / 2; i += 512) { const int bsel = i / (16 * TP / 2), w = i % (16 * TP / 2); ((LAS unsigned*)(lds + bsel * P4_BUF + P4_VT + 128 * TP * 2))[w] = 0u; }
    }
    __syncthreads();
    const int u0 = vcu * (NUNIT / 256);
    P4Regs R; p4_prefetch(a, u0, R);
    for (int i = 0; i < NUNIT / 256; ++i) {
        const int u = u0 + i, h = u & 3, c = (u >> 2) & (NCH - 1), b = u >> 9, r0 = b * SEQ + c * CH, seq0 = c * CH;
        LAS unsigned char* buf = lds + (i & 1) * P4_BUF;
        LAS bf16_t* KT = (LAS bf16_t*)(buf + P4_KT); LAS bf16_t* VT = (LAS bf16_t*)(buf + P4_VT); LAS bf16_t* Us = (LAS bf16_t*)(buf + P4_US);
        bf16_t* a2 = (bf16_t*)(ws + WS_A2);
        float bc = R.lf;
#pragma unroll
        for (int o = 1; o < 64; o <<= 1) { const float t = __shfl_up(bc, o); if (lane >= o) bc += t; }
        const float Bt = __shfl(bc, 63), g = Bt - bc + R.ig, ml = wave_max(g), w = __expf(g - ml);
        if (tid == 0) { ((float*)(ws + WS_UB))[u] = Bt; ((float*)(ws + WS_UM))[u] = ml; }
#pragma unroll
        for (int it = 0; it < 2; ++it) { const int dg = wave + 8 * it; float o[8];
            conv_taps(R.kt[it], cw, ZC_K + h * DH + dg * 8, o);
#pragma unroll
            for (int e = 0; e < 8; ++e) o[e] *= 0.08838834764831845f;
            u32x4 kw; kw.x = cvt_pk_bf16(o[0], o[1]); kw.y = cvt_pk_bf16(o[2], o[3]); kw.z = cvt_pk_bf16(o[4], o[5]); kw.w = cvt_pk_bf16(o[6], o[7]);
            *(u32x4*)(a2 + (size_t)(r0 + lane) * D + h * DH + dg * 8) = kw;
            const unsigned kk[4] = {kw.x, kw.y, kw.z, kw.w};
#pragma unroll
            for (int e = 0; e < 4; ++e) { KT[(dg * 8 + 2 * e) * TP + lane] = (bf16_t)(kk[e] & 0xffffu); KT[(dg * 8 + 2 * e + 1) * TP + lane] = (bf16_t)(kk[e] >> 16); } }
#pragma unroll
        for (int it = 0; it < 2; ++it) { const int vg = wave + 8 * it; float f[8]; unpack8(R.vv[it], f);
#pragma unroll
            for (int e = 0; e < 8; ++e) VT[(vg * 8 + e) * TP + lane] = f2bf(f[e] * w); }
        if (wave == 0) VT[128 * TP + lane] = f2bf(w);
#pragma unroll
        for (int it = 0; it < 3; ++it) { const int idx = tid + 512 * it, row = idx >> 4, cg = idx & 15; if (idx < 79 * 16) *(LAS u32x4*)(Us + row * QP + cg * 8) = R.uu[it]; }
        __syncthreads();
        if (i + 1 < NUNIT / 256) p4_prefetch(a, u + 1, R);
        {
            bf16_t* dc = (bf16_t*)(ws + WS_CST) + (size_t)u * DH * DH;
            const int v0 = wave * 16;
            const bf16x8 bv0 = ldfrag(VT, TP, v0 + fr, 8 * fq), bv1 = ldfrag(VT, TP, v0 + fr, 32 + 8 * fq);
            const bf16x8 nv0 = ldfrag(VT, TP, 128 + fr, 8 * fq), nv1 = ldfrag(VT, TP, 128 + fr, 32 + 8 * fq);
#pragma unroll
            for (int dt = 0; dt < 8; ++dt) {
                const bf16x8 a0 = ldfrag(KT, TP, dt * 16 + fr, 8 * fq), a1 = ldfrag(KT, TP, dt * 16 + fr, 32 + 8 * fq);
                f32x4 acc = {0.f, 0.f, 0.f, 0.f};
                acc = __builtin_amdgcn_mfma_f32_16x16x32_bf16(a0, bv0, acc, 0, 0, 0);
                acc = __builtin_amdgcn_mfma_f32_16x16x32_bf16(a1, bv1, acc, 0, 0, 0);
                u32x2 wv; wv.x = cvt_pk_bf16(acc[0], acc[1]); wv.y = cvt_pk_bf16(acc[2], acc[3]);
                *(u32x2*)(dc + (size_t)(v0 + fr) * DH + dt * 16 + 4 * fq) = wv;
                if (wave == dt) { f32x4 an = {0.f, 0.f, 0.f, 0.f};
                    an = __builtin_amdgcn_mfma_f32_16x16x32_bf16(a0, nv0, an, 0, 0, 0);
                    an = __builtin_amdgcn_mfma_f32_16x16x32_bf16(a1, nv1, an, 0, 0, 0);
                    if (fr == 0) *(f32x4*)((float*)(ws + WS_NST) + (size_t)u * DH + dt * 16 + 4 * fq) = an; }
            }
        }
        if (h == 0) p4_pool<2>(Us, a2, r0, seq0, h, tid); else if (h == 1) p4_pool<4>(Us, a2, r0, seq0, h, tid); else if (h == 2) p4_pool<8>(Us, a2, r0, seq0, h, tid); else p4_pool<16>(Us, a2, r0, seq0, h, tid);
    }
    __syncthreads();
}

struct P5Batch { u32x2 dv[8]; float dn[8], Bt[8], ml[8]; };
__device__ __forceinline__ void p5_load(const Args& a, int b, int h, int cb, int eoff, bool do_n, P5Batch& B) {
    const bf16_t* dcs = (const bf16_t*)(a.ws + WS_CST); const float* dns = (const float*)(a.ws + WS_NST);
    const float* uB = (const float*)(a.ws + WS_UB); const float* uM = (const float*)(a.ws + WS_UM);
#pragma unroll
    for (int i = 0; i < 8; ++i) { const int u = ((b * NCH + cb + i) << 2) + h;
        B.dv[i] = *(const u32x2*)(dcs + (size_t)u * DH * DH + eoff); B.dn[i] = do_n ? dns[(size_t)u * DH + threadIdx.x] : 0.f; B.Bt[i] = uB[u]; B.ml[i] = uM[u]; }
}
struct P5State { float C0, C1, C2, C3, nn, mst; };
__device__ __forceinline__ void p5_step(const Args& a, int b, int h, int cb, int eoff, bool do_n, bool do_m, const P5Batch& B, P5State& S) {
    bf16_t* cst = (bf16_t*)(a.ws + WS_CST); float* nst = (float*)(a.ws + WS_NST2); float* uMS = (float*)(a.ws + WS_UMS);
#pragma unroll
    for (int i = 0; i < 8; ++i) { const int u = ((b * NCH + cb + i) << 2) + h;
        const float mn = fmaxf(B.Bt[i] + S.mst, B.ml[i]), dec = __expf(B.Bt[i] + S.mst - mn), sc = __expf(B.ml[i] - mn);
        S.C0 = dec * S.C0 + sc * bf_lo(B.dv[i].x); S.C1 = dec * S.C1 + sc * bf_hi(B.dv[i].x); S.C2 = dec * S.C2 + sc * bf_lo(B.dv[i].y); S.C3 = dec * S.C3 + sc * bf_hi(B.dv[i].y);
        S.nn = dec * S.nn + sc * B.dn[i]; S.mst = mn;
        u32x2 w; w.x = cvt_pk_bf16(S.C0, S.C1); w.y = cvt_pk_bf16(S.C2, S.C3);
        *(u32x2*)(cst + (size_t)u * DH * DH + eoff) = w;
        if (do_n) nst[(size_t)u * DH + threadIdx.x] = S.nn;
        if (do_m) uMS[u] = mn; }
}
__device__ __forceinline__ void p5_scan(const Args& a, int wg) {
    const int tid = threadIdx.x, stream = wg >> 3, slice = wg & 7, b = stream >> 2, h = stream & 3;
    const int eoff = (slice * 16 + (tid >> 5)) * DH + (tid & 31) * 4;
    const bool do_n = (slice == 0) && (tid < 128), do_m = (slice == 0) && (tid == 0);
    P5State S{0.f, 0.f, 0.f, 0.f, 0.f, 0.f}; P5Batch A, Bb;
    p5_load(a, b, h, 0, eoff, do_n, A);
    for (int cb = 0; cb < NCH; cb += 16) {
        p5_load(a, b, h, cb + 8, eoff, do_n, Bb);
        p5_step(a, b, h, cb, eoff, do_n, do_m, A, S);
        if (cb + 16 < NCH) p5_load(a, b, h, cb + 16, eoff, do_n, A);
        p5_step(a, b, h, cb + 8, eoff, do_n, do_m, Bb, S);
    }
}

struct P6Regs { u32x4 qt[2][4]; u32x4 kc[2]; u32x4 vv[2]; u32x4 cc[4]; u32x2 so[4]; f32x4 gn; float nn, lf, ig, mp; };
constexpr int P6_Q = 0, P6_K = 17408, P6_VT = 34816, P6_C = 53248, P6_P = 88064, P6_SM = 97280, P6_CW = 101632;
__device__ __forceinline__ void p6_prefetch(const Args& a, int u, P6Regs& R) {
    const bf16_t* z = (const bf16_t*)(a.ws + WS_Z); const float* zif = (const float*)(a.ws + WS_ZIF); const bf16_t* a2 = (const bf16_t*)(a.ws + WS_A2);
    const int tid = threadIdx.x, lane = tid & 63, wave = tid >> 6, fr = lane & 15, fq = lane >> 4;
    const int h = u & 3, c = (u >> 2) & (NCH - 1), b = u >> 9, r0 = b * SEQ + c * CH, seq0 = c * CH;
    R.lf = 0.f; R.ig = 0.f; R.mp = 0.f;
    if (wave == 0) { R.lf = zif[(size_t)(r0 + lane) * 8 + 4 + h]; R.ig = zif[(size_t)(r0 + lane) * 8 + h]; if (c > 0) R.mp = ((const float*)(a.ws + WS_UMS))[u - NH]; }
#pragma unroll
    for (int it = 0; it < 2; ++it) { const int idx = tid + 512 * it, s = idx >> 4, dg = idx & 15;
        load_taps(z, r0, s, seq0, ZC_Q + h * DH + dg * 8, R.qt[it]);
        R.kc[it] = *(const u32x4*)(a2 + (size_t)(r0 + s) * D + h * DH + dg * 8); }
#pragma unroll
    for (int it = 0; it < 2; ++it) R.vv[it] = *(const u32x4*)(z + (size_t)(r0 + lane) * ZW + ZC_V + h * DH + (wave + 8 * it) * 8);
    const bf16_t* cp = (const bf16_t*)(a.ws + WS_CST) + (size_t)(u - NH) * DH * DH;
#pragma unroll
    for (int it = 0; it < 4; ++it) { const int idx = tid + 512 * it, v = idx >> 4, dg = idx & 15; R.cc[it] = (u32x4){0u, 0u, 0u, 0u}; if (c > 0) R.cc[it] = *(const u32x4*)(cp + v * DH + dg * 8); }
    R.nn = 0.f; if (c > 0 && tid < 128) R.nn = ((const float*)(a.ws + WS_NST2))[(size_t)(u - NH) * DH + tid];
#pragma unroll
    for (int tt = 0; tt < 4; ++tt) R.so[tt] = *(const u32x2*)(z + (size_t)(r0 + tt * 16 + fr) * ZW + ZC_O + h * DH + wave * 16 + 4 * fq);
    R.gn = *(const f32x4*)(a.hng + h * DH + wave * 16 + 4 * fq);
}
__device__ __forceinline__ void p6_phase(const Args& a, LAS unsigned char* lds, int vcu) {
    unsigned char* ws = a.ws;
    const int tid = threadIdx.x, lane = tid & 63, wave = tid >> 6, fr = lane & 15, fq = lane >> 4;
    LAS bf16_t* Qs = (LAS bf16_t*)(lds + P6_Q); LAS bf16_t* Ks = (LAS bf16_t*)(lds + P6_K); LAS bf16_t* VT = (LAS bf16_t*)(lds + P6_VT);
    LAS bf16_t* Cs = (LAS bf16_t*)(lds + P6_C); LAS bf16_t* Ps = (LAS bf16_t*)(lds + P6_P);
    LAS float* sN = (LAS float*)(lds + P6_SM); LAS float* sWi = sN + 128; LAS float* sRt = sWi + 64; LAS float* sE = sRt + 64; LAS float* sFl = sE + 64;
    LAS float* rsum = sFl + 64; LAS float* nqs = rsum + 128; LAS float* ssqp = nqs + 64;
    LAS float* cw = (LAS float*)(lds + P6_CW);
#pragma unroll
    for (int it = 0; it < 2; ++it) *(LAS f32x4*)(cw + (tid + 512 * it) * 4) = *(const f32x4*)(a.convw + (tid + 512 * it) * 4);
    __syncthreads();
    const int u0 = vcu * (NUNIT / 256);
    P6Regs R; p6_prefetch(a, u0, R);
    for (int i = 0; i < NUNIT / 256; ++i) {
        const int u = u0 + i, h = u & 3, c = (u >> 2) & (NCH - 1), b = u >> 9, r0 = b * SEQ + c * CH;
        bf16_t* a2 = (bf16_t*)(ws + WS_A2);
        if (wave == 0) {
            float bc = R.lf;
#pragma unroll
            for (int o = 1; o < 64; o <<= 1) { const float t = __shfl_up(bc, o); if (lane >= o) bc += t; }
            const float e = R.ig - bc; float cm = e;
#pragma unroll
            for (int o = 1; o < 64; o <<= 1) { const float t = __shfl_up(cm, o); if (lane >= o) cm = fmaxf(cm, t); }
            const float ai = bc + R.mp, mt = fmaxf(ai, bc + cm);
            sWi[lane] = __expf(ai - mt); sRt[lane] = bc - mt; sE[lane] = e; sFl[lane] = __expf(-mt);
        }
#pragma unroll
        for (int it = 0; it < 2; ++it) { const int idx = tid + 512 * it, s = idx >> 4, dg = idx & 15; float o[8];
            conv_taps(R.qt[it], cw, ZC_Q + h * DH + dg * 8, o);
            u32x4 w; w.x = cvt_pk_bf16(o[0], o[1]); w.y = cvt_pk_bf16(o[2], o[3]); w.z = cvt_pk_bf16(o[4], o[5]); w.w = cvt_pk_bf16(o[6], o[7]);
            *(LAS u32x4*)(Qs + s * QP + dg * 8) = w;
            *(LAS u32x4*)(Ks + s * QP + dg * 8) = R.kc[it]; }
#pragma unroll
        for (int it = 0; it < 2; ++it) { const int vg = wave + 8 * it; const unsigned wv[4] = {R.vv[it].x, R.vv[it].y, R.vv[it].z, R.vv[it].w};
#pragma unroll
            for (int e = 0; e < 4; ++e) { VT[(vg * 8 + 2 * e) * TP + lane] = (bf16_t)(wv[e] & 0xffffu); VT[(vg * 8 + 2 * e + 1) * TP + lane] = (bf16_t)(wv[e] >> 16); } }
#pragma unroll
        for (int it = 0; it < 4; ++it) { const int idx = tid + 512 * it, v = idx >> 4, dg = idx & 15; *(LAS u32x4*)(Cs + v * QP + dg * 8) = R.cc[it]; }
        if (tid < 128) sN[tid] = R.nn;
        const u32x2 so0 = R.so[0], so1 = R.so[1], so2 = R.so[2], so3 = R.so[3]; const f32x4 gn = R.gn;
        __syncthreads();
        if (i + 1 < NUNIT / 256) p6_prefetch(a, u + 1, R);
        {
            const int t0 = (wave & 3) * 16, t = t0 + fr;
            bf16x8 qf[4];
#pragma unroll
            for (int kk = 0; kk < 4; ++kk) qf[kk] = ldfrag(Qs, QP, t, 32 * kk + 8 * fq);
            const float rt = sRt[t]; float ps = 0.f;
#pragma unroll
            for (int i2 = 0; i2 < 2; ++i2) { const int s0 = ((wave >> 2) * 2 + i2) * 16;
                f32x4 acc = {0.f, 0.f, 0.f, 0.f};
#pragma unroll
                for (int kk = 0; kk < 4; ++kk) acc = __builtin_amdgcn_mfma_f32_16x16x32_bf16(ldfrag(Ks, QP, s0 + fr, 32 * kk + 8 * fq), qf[kk], acc, 0, 0, 0);
                float p[4];
#pragma unroll
                for (int j = 0; j < 4; ++j) { const int s = s0 + 4 * fq + j; p[j] = s <= t ? acc[j] * __expf(rt + sE[s]) : 0.f; }
                u32x2 w; w.x = cvt_pk_bf16(p[0], p[1]); w.y = cvt_pk_bf16(p[2], p[3]);
                *(LAS u32x2*)(Ps + t * TP + s0 + 4 * fq) = w;
                ps += (bf_lo(w.x) + bf_hi(w.x)) + (bf_lo(w.y) + bf_hi(w.y)); }
            ps += __shfl_xor(ps, 16); ps += __shfl_xor(ps, 32);
            if (fq == 0) rsum[t * 2 + (wave >> 2)] = ps;
            const int t2 = tid >> 3, part = tid & 7; float nq = 0.f;
#pragma unroll
            for (int d = 0; d < 16; ++d) nq += sN[part * 16 + d] * __uint_as_float((unsigned)Qs[t2 * QP + part * 16 + d] << 16);
            nq += __shfl_xor(nq, 1); nq += __shfl_xor(nq, 2); nq += __shfl_xor(nq, 4);
            if (part == 0) nqs[t2] = nq;
        }
        __syncthreads();
        f32x4 hv[4];
        {
            const int v0 = wave * 16;
            bf16x8 cf[4], vf[2];
#pragma unroll
            for (int kk = 0; kk < 4; ++kk) cf[kk] = ldfrag(Cs, QP, v0 + fr, 32 * kk + 8 * fq);
#pragma unroll
            for (int kk = 0; kk < 2; ++kk) vf[kk] = ldfrag(VT, TP, v0 + fr, 32 * kk + 8 * fq);
#pragma unroll
            for (int tt = 0; tt < 4; ++tt) { const int t = tt * 16 + fr;
                f32x4 ai = {0.f, 0.f, 0.f, 0.f}, ap = {0.f, 0.f, 0.f, 0.f};
#pragma unroll
                for (int kk = 0; kk < 4; ++kk) ai = __builtin_amdgcn_mfma_f32_16x16x32_bf16(cf[kk], ldfrag(Qs, QP, t, 32 * kk + 8 * fq), ai, 0, 0, 0);
#pragma unroll
                for (int kk = 0; kk < 2; ++kk) ap = __builtin_amdgcn_mfma_f32_16x16x32_bf16(vf[kk], ldfrag(Ps, TP, t, 32 * kk + 8 * fq), ap, 0, 0, 0);
                const float wi = sWi[t], den = wi * nqs[t] + (rsum[2 * t] + rsum[2 * t + 1]), inv = 1.0f / fmaxf(fabsf(den), sFl[t]);
                hv[tt] = (ai * wi + ap) * inv;
                float q = (hv[tt][0] * hv[tt][0] + hv[tt][1] * hv[tt][1]) + (hv[tt][2] * hv[tt][2] + hv[tt][3] * hv[tt][3]);
                q += __shfl_xor(q, 16); q += __shfl_xor(q, 32);
                if (fq == 0) ssqp[t * 8 + wave] = q; }
        }
        __syncthreads();
        {
            const u32x2 sov[4] = {so0, so1, so2, so3};
#pragma unroll
            for (int tt = 0; tt < 4; ++tt) { const int t = tt * 16 + fr;
                const f32x4 q0 = *(const LAS f32x4*)(ssqp + t * 8), q1 = *(const LAS f32x4*)(ssqp + t * 8 + 4);
                const float rn = __builtin_amdgcn_rsqf(((q0[0] + q0[1]) + (q0[2] + q0[3]) + (q1[0] + q1[1]) + (q1[2] + q1[3])) * (1.0f / DH) + EPS);
                u32x2 w; w.x = cvt_pk_bf16(hv[tt][0] * rn * gn[0] * bf_lo(sov[tt].x), hv[tt][1] * rn * gn[1] * bf_hi(sov[tt].x));
                w.y = cvt_pk_bf16(hv[tt][2] * rn * gn[2] * bf_lo(sov[tt].y), hv[tt][3] * rn * gn[3] * bf_hi(sov[tt].y));
                *(u32x2*)(a2 + (size_t)(r0 + t) * D + h * DH + wave * 16 + 4 * fq) = w; }
        }
    }
    __syncthreads();
}

__device__ __forceinline__ void p_final(const Args& a, int gw, int NGW, int lane) {
    const f32x4* gp = (const f32x4*)a.fng + lane; f32x4 g[4];
#pragma unroll
    for (int j = 0; j < 4; ++j) g[j] = gp[64 * j];
    for (int m = gw; m < M; m += NGW) {
        f32x4* xr = (f32x4*)(a.out + (size_t)m * D) + lane; f32x4 v[4]; float s = 0.f;
#pragma unroll
        for (int j = 0; j < 4; ++j) { v[j] = xr[64 * j]; s += (v[j][0] * v[j][0] + v[j][1] * v[j][1]) + (v[j][2] * v[j][2] + v[j][3] * v[j][3]); }
        const float r = __builtin_amdgcn_rsqf(wave_sum(s) * (1.0f / D) + EPS);
#pragma unroll
        for (int j = 0; j < 4; ++j) xr[64 * j] = v[j] * r * g[j];
    }
}

__global__ void __launch_bounds__(512, 2) fwd_kernel(Args a) {
    extern __shared__ __attribute__((aligned(16))) unsigned char lds_raw[];
    LAS unsigned char* lds = (LAS unsigned char*)lds_raw;
    volatile LAS unsigned* MISC = (volatile LAS unsigned*)(lds + MISC_OFF);
    const int tid = threadIdx.x, lane = tid & 63, wave = __builtin_amdgcn_readfirstlane(tid >> 6);
    const int G = gridDim.x, bx = blockIdx.x;
    const int vcu = (G % 8 == 0) ? (bx % 8) * (G / 8) + bx / 8 : bx;
    const int gw = vcu * 8 + wave, NGW = G * 8;
    unsigned char* ws = a.ws;
    if (tid < 32) MISC[tid] = 0u;
    __syncthreads();
    XcdBarrier bar; bar.bar = (unsigned*)(ws + WS_CTL) + CW_BAR; bar.x = 0; bar.st = nullptr;
    if (MK_N_LAUNCHES == 1) bar = xcd_barrier_post((unsigned*)(ws + WS_CTL) + CW_BAR, MISC + 8);
    const int lo = a.ph_lo, hi = a.ph_hi;
#define IN(k) (lo <= (k) && (k) < hi)
#define SEAM(k) do { if (IN(k) && IN((k) + 1)) xcd_barrier(bar); } while (0)
    bf16_t* const HB = (bf16_t*)(ws + WS_H); bf16_t* const A2 = (bf16_t*)(ws + WS_A2); bf16_t* const MG = (bf16_t*)(ws + WS_CST); bf16_t* const ZB = (bf16_t*)(ws + WS_Z); bf16_t* const ACT = ZB;
    float* const SS = (float*)(ws + WS_SS);
    LAS float* const EP = (LAS float*)(lds + EPI_OFF);

    if (IN(0)) { p0_prologue(a, lds, gw, NGW, lane, wave); }
    SEAM(0);
    if (IN(1)) {
        pg8::Gemm g{HB, (const bf16_t*)(ws + WS_WGU1), M, NGU, D, D, D}; pg8::StaticOrder S; S.init(M, NGU, G, bx);
        pg8::EpiSwiGLU<false> E{ACT, SS}; pg8::gemm_phase<pg8::EpiSwiGLU<false>, true>(lds, g, S, E);
    }
    SEAM(1);
    if (IN(2)) {
        pg8::Gemm g{ACT, (const bf16_t*)(ws + WS_WDN1), M, D, DFF, DFF, DFF}; pg8::StaticOrder S; S.init(M, D, G, bx);
        pg8::EpiResid<false, true> E{a.x, HB, SS, 0.5f, EP}; pg8::gemm_phase<pg8::EpiResid<false, true>, true>(lds, g, S, E);
    }
    SEAM(2);
    if (IN(3)) {
        pg8::Gemm g{HB, (const bf16_t*)(ws + WS_WIN), M, NIN, D, D, D}; pg8::StaticOrder S; S.init(M, NIN, G, bx);
        pg8::EpiWin E{ZB, (float*)(ws + WS_ZIF), a.bin, SS}; pg8::gemm_phase<pg8::EpiWin, true>(lds, g, S, E);
    }
    SEAM(3);
    if (IN(4)) { p4_phase(a, lds, vcu); }
    SEAM(4);
    if (IN(5)) { p5_scan(a, vcu); }
    SEAM(5);
    if (IN(6)) { p6_phase(a, lds, vcu); }
    SEAM(6);
    if (IN(7)) {
        { pg8::Gemm g{A2, (const bf16_t*)(ws + WS_WAB), M, D, 512, D, D}; pg8::StaticOrder S; S.init(M, D, G, bx);
          pg8::EpiMerge<false> E{MG, ZB, ZC_GA}; pg8::gemm_phase<pg8::EpiMerge<false>, true>(lds, g, S, E); }
        { pg8::Gemm g{A2 + 512, (const bf16_t*)(ws + WS_WAB) + 512, M, D, 512, D, D}; pg8::StaticOrder S; S.init(M, D, G, bx);
          pg8::EpiMerge<true> E{MG, ZB, ZC_GB}; pg8::gemm_phase<pg8::EpiMerge<true>, true>(lds, g, S, E); }
    }
    SEAM(7);
    if (IN(8)) {
        pg8::Gemm g{MG, (const bf16_t*)(ws + WS_WOUT), M, D, D, D, D}; pg8::StaticOrder S; S.init(M, D, G, bx);
        pg8::EpiResid<true, true> E{HB, A2, SS, 1.0f, EP}; pg8::gemm_phase<pg8::EpiResid<true, true>, true>(lds, g, S, E);
    }
    SEAM(8);
    if (IN(9)) {
        pg8::Gemm g{A2, (const bf16_t*)(ws + WS_WGU2), M, NGU, D, D, D}; pg8::StaticOrder S; S.init(M, NGU, G, bx);
        pg8::EpiSwiGLU<true> E{ACT, SS}; pg8::gemm_phase<pg8::EpiSwiGLU<true>, true>(lds, g, S, E);
    }
    SEAM(9);
    if (IN(10)) {
        pg8::Gemm g{ACT, (const bf16_t*)(ws + WS_WDN2), M, D, DFF, DFF, DFF}; pg8::StaticOrder S; S.init(M, D, G, bx);
        pg8::EpiResid<true, false> E{A2, a.out, nullptr, 0.5f, EP}; pg8::gemm_phase<pg8::EpiResid<true, false>, true>(lds, g, S, E);
    }
    SEAM(10);
    if (IN(11)) { p_final(a, gw, NGW, lane); }
#undef IN
#undef SEAM
}

extern "C" void kernel_launch(void* const* d_in, const int* in_sizes, int n_in, void* d_out, int out_size, void* d_ws, size_t ws_size, hipStream_t stream) {
    static int grid = 0;
    if (grid == 0) {
        if (n_in != 18 || in_sizes[0] != M * D || out_size != M * D || ws_size < WS_END) { fprintf(stderr, "kernel_launch: unexpected problem (n_in %d, in0 %d, out %d, ws %zu)\n", n_in, n_in > 0 ? in_sizes[0] : -1, out_size, ws_size); grid = -1; return; }
        int dev = 0, cus = 0, per_cu = 0;
        if (hipGetDevice(&dev) != hipSuccess || hipDeviceGetAttribute(&cus, hipDeviceAttributeMultiprocessorCount, dev) != hipSuccess) { grid = -1; return; }
        if (hipFuncSetAttribute((const void*)fwd_kernel, hipFuncAttributeMaxDynamicSharedMemorySize, LDS_BYTES) != hipSuccess) { fprintf(stderr, "kernel_launch: hipFuncSetAttribute failed\n"); grid = -1; return; }
        if (hipOccupancyMaxActiveBlocksPerMultiprocessor(&per_cu, (const void*)fwd_kernel, 512, LDS_BYTES) != hipSuccess || per_cu < 1) { fprintf(stderr, "kernel_launch: occupancy query reports %d\n", per_cu); }
        (void)hipGetLastError();
        grid = cus;
        if (grid != 256) { fprintf(stderr, "kernel_launch: %d CUs; this kernel is laid out for 256\n", grid); grid = -1; return; }
    }
    if (grid < 0) return;
    if (hipMemsetAsync((char*)d_ws + WS_CTL, 0, CTL_ZERO_BYTES, stream) != hipSuccess) return;
    Args a{};
    a.x = (const float*)d_in[0]; a.n1g = (const float*)d_in[1]; a.wgu1 = (const float*)d_in[2]; a.wdn1 = (const float*)d_in[3]; a.mng = (const float*)d_in[4];
    a.win = (const float*)d_in[5]; a.bin = (const float*)d_in[6]; a.convw = (const float*)d_in[7]; a.hng = (const float*)d_in[8]; a.pa = (const float*)d_in[9];
    a.wpool = (const float*)d_in[10]; a.pscale = (const float*)d_in[11]; a.pb = (const float*)d_in[12]; a.wout = (const float*)d_in[13]; a.n2g = (const float*)d_in[14];
    a.wgu2 = (const float*)d_in[15]; a.wdn2 = (const float*)d_in[16]; a.fng = (const float*)d_in[17];
    a.out = (float*)d_out; a.ws = (unsigned char*)d_ws;
    if (MK_N_LAUNCHES == 1) { a.ph_lo = 0; a.ph_hi = NPHASE; hipLaunchKernelGGL(fwd_kernel, dim3(grid), dim3(512), LDS_BYTES, stream, a); }
    else for (int p = 0; p < NPHASE; ++p) { a.ph_lo = p; a.ph_hi = p + 1; hipLaunchKernelGGL(fwd_kernel, dim3(grid), dim3(512), LDS_BYTES, stream, a); }
}
```
